# Optimizing an MI355X kernel written in HIP

```python
import math
import jax, jax.numpy as jnp
from jax import lax
import numpy as np

D_MODEL = 1024
BATCH = 16
SEQ = 4096
DEPTH = 2
DEC_BATCH = 2
DEC_SEQ = 16384
PAST_LEN = 128

HEAD_DIM = 64
EPS = 1e-6
H_A = 4
W_A = H_A * 2 * HEAD_DIM
Q_BLOCK = 128
H_B = 8
W_B = H_B * HEAD_DIM
GRID_W = 64
MAX_KH = 8
KW = 16
H_C = 8
KV_C = 2
W_C = H_C * HEAD_DIM
KV_W_C = KV_C * HEAD_DIM
WINDOW = 128
BLOCK = 128

_SIZES = (W_A, W_A, W_A, W_A,
          W_B, W_B, W_B, W_B,
          W_C, KV_W_C, KV_W_C, W_C,
          D_MODEL, D_MODEL, D_MODEL)
IN_COLS = sum(_SIZES)
SPLIT_POINTS = tuple(sum(_SIZES[:i + 1]) for i in range(len(_SIZES) - 1))

kernel_name = "hybrid_diff_na2d_swa_encoder"


def rms_norm(x, g):
    xf = x.astype(jnp.float32)
    y = xf * lax.rsqrt(jnp.mean(xf * xf, axis=-1, keepdims=True) + EPS)
    return (y * g.astype(jnp.float32)).astype(x.dtype)


def alibi_slopes(n):
    return jnp.asarray(np.array([2.0 ** (-8.0 * (i + 1) / n) for i in range(n)], dtype=np.float32))


def diff_attention(q, k, v, lam, lam_init, subln_g):
    B, T = q.shape[0], q.shape[1]
    nq = T // Q_BLOCK
    slopes = alibi_slopes(H_A)[None, :, None, None, None]
    kpos = jnp.arange(T)
    scale = HEAD_DIM ** -0.5
    qb = q.reshape(B, nq, Q_BLOCK, H_A, 2, HEAD_DIM).transpose(1, 0, 2, 3, 4, 5)

    def block(args):
        qi, i = args
        s = jnp.einsum('bqhcd,bkhcd->bhcqk', qi, k).astype(jnp.float32) * scale
        qpos = i * Q_BLOCK + jnp.arange(Q_BLOCK)
        dist = jnp.abs(qpos[:, None] - kpos[None, :]).astype(jnp.float32)
        p = jax.nn.softmax(s - slopes * dist, axis=-1)
        a = p[:, :, 0] - lam * p[:, :, 1]
        return jnp.einsum('bhqk,bkhe->bqhe', a.astype(v.dtype), v)

    o = lax.map(block, (qb, jnp.arange(nq)))
    o = o.transpose(1, 0, 2, 3, 4).reshape(B, T, H_A, 2 * HEAD_DIM)
    o = rms_norm(o, subln_g) * (1.0 - lam_init)
    return o.reshape(B, T, W_A)


def neighbourhood_attention(q, k, v, rpb):
    B, T = q.shape[0], q.shape[1]
    rows = T // GRID_W
    kh = min(MAX_KH, rows)
    qg = q.reshape(B, rows, GRID_W, H_B, HEAD_DIM)
    kg = k.reshape(B, rows, GRID_W, H_B, HEAD_DIM)
    vg = v.reshape(B, rows, GRID_W, H_B, HEAD_DIM)
    cols = jnp.arange(GRID_W)
    cstart = jnp.clip(cols - KW // 2, 0, GRID_W - KW)
    cidx = cstart[:, None] + jnp.arange(KW)[None, :]
    dc = cidx - cols[:, None] + (KW - 1)
    scale = HEAD_DIM ** -0.5

    def row(r):
        rs = jnp.clip(r - kh // 2, 0, rows - kh)
        q_r = lax.dynamic_index_in_dim(qg, r, axis=1, keepdims=False)
        k_rows = lax.dynamic_slice_in_dim(kg, rs, kh, axis=1)
        v_rows = lax.dynamic_slice_in_dim(vg, rs, kh, axis=1)
        k_n = k_rows[:, :, cidx]
        v_n = v_rows[:, :, cidx]
        dr = rs + jnp.arange(kh) - r + (MAX_KH - 1)
        bias = rpb[:, dr[None, :, None], dc[:, None, :]].astype(jnp.float32)
        s = jnp.einsum('bchd,bicjhd->bhcij', q_r, k_n).astype(jnp.float32) * scale + bias[None]
        p = jax.nn.softmax(s.reshape(B, H_B, GRID_W, kh * KW), axis=-1)
        p = p.reshape(B, H_B, GRID_W, kh, KW).astype(v.dtype)
        return jnp.einsum('bhcij,bicjhd->bchd', p, v_n)

    o = lax.map(row, jnp.arange(rows))
    return o.transpose(1, 0, 2, 3, 4).reshape(B, T, W_B)


def sliding_window_attention(q, k, v, sink):
    B, T = q.shape[0], q.shape[1]
    n = T // BLOCK
    G = H_C // KV_C
    scale = HEAD_DIM ** -0.5

    def band(a):
        ap = jnp.pad(a, ((0, 0), (BLOCK, BLOCK), (0, 0), (0, 0))).reshape(B, n + 2, BLOCK, KV_C, HEAD_DIM)
        return jnp.concatenate([ap[:, :-2], ap[:, 1:-1], ap[:, 2:]], axis=2)

    kb, vb = band(k), band(v)
    qb = q.reshape(B, n, BLOCK, KV_C, G, HEAD_DIM)
    s = jnp.einsum('bnqkgd,bnskd->bnkgqs', qb, kb).astype(jnp.float32) * scale
    qpos = jnp.arange(n)[:, None] * BLOCK + jnp.arange(BLOCK)[None, :]
    kpos = jnp.arange(n)[:, None] * BLOCK - BLOCK + jnp.arange(3 * BLOCK)[None, :]
    dist_i = jnp.abs(qpos[:, :, None] - kpos[:, None, :])
    valid = (dist_i <= WINDOW) & (kpos >= 0)[:, None, :] & (kpos < T)[:, None, :]
    dist = dist_i.astype(jnp.float32)[:, None, None]
    slopes = alibi_slopes(H_C).reshape(KV_C, G)[:, :, None, None]
    s = jnp.where(valid[:, None, None], s - slopes * dist, -1e30)
    sink_col = jnp.broadcast_to(sink.astype(jnp.float32).reshape(KV_C, G)[None, None, :, :, None, None],
                                s.shape[:-1] + (1,))
    p = jax.nn.softmax(jnp.concatenate([s, sink_col], axis=-1), axis=-1)[..., :-1]
    o = jnp.einsum('bnkgqs,bnskd->bnqkgd', p.astype(v.dtype), vb)
    return o.reshape(B, T, W_C)


def trunk(x, norm_g, w_in, qk_gain_a, lambda_a, subln_g_a, qk_gain_b, rpb_b,
          qk_gain_c, sink_c, w_proj_a, w_proj_b, w_proj_c, w_out):
    B, T = x.shape[0], x.shape[1]
    for l in range(DEPTH):
        h = rms_norm(x, norm_g[l])
        p = jnp.einsum('btd,dc->btc', h, w_in[l])
        (qa, ka, va, za, qb, kb, vb, zb, qc, kc, vc, zc,
         ga, gb, gc) = jnp.split(p, SPLIT_POINTS, axis=-1)
        lam_init = 0.8 - 0.6 * math.exp(-0.3 * l)
        lam_vec = lambda_a[l].astype(jnp.float32)
        lam = (jnp.exp(jnp.sum(lam_vec[0] * lam_vec[1])) - jnp.exp(jnp.sum(lam_vec[2] * lam_vec[3]))
               + lam_init)
        qa = rms_norm(qa.reshape(B, T, H_A, 2, HEAD_DIM), qk_gain_a[l, 0])
        ka = rms_norm(ka.reshape(B, T, H_A, 2, HEAD_DIM), qk_gain_a[l, 1])
        oa = diff_attention(qa, ka, va.reshape(B, T, H_A, 2 * HEAD_DIM), lam, lam_init, subln_g_a[l])
        qb = rms_norm(qb.reshape(B, T, H_B, HEAD_DIM), qk_gain_b[l, 0])
        kb = rms_norm(kb.reshape(B, T, H_B, HEAD_DIM), qk_gain_b[l, 1])
        ob = neighbourhood_attention(qb, kb, vb.reshape(B, T, H_B, HEAD_DIM), rpb_b[l])
        qc = rms_norm(qc.reshape(B, T, H_C, HEAD_DIM), qk_gain_c[l, 0])
        kc = rms_norm(kc.reshape(B, T, KV_C, HEAD_DIM), qk_gain_c[l, 1])
        oc = sliding_window_attention(qc, kc, vc.reshape(B, T, KV_C, HEAD_DIM), sink_c[l])
        ya = jnp.einsum('btw,wd->btd', oa * jax.nn.silu(za), w_proj_a[l])
        yb = jnp.einsum('btw,wd->btd', ob * jax.nn.silu(zb), w_proj_b[l])
        yc = jnp.einsum('btw,wd->btd', oc * jax.nn.silu(zc), w_proj_c[l])
        m = jax.nn.sigmoid(ga) * ya + jax.nn.sigmoid(gb) * yb + jax.nn.sigmoid(gc) * yc
        x = x + jnp.einsum('btd,de->bte', m, w_out[l])
    return x


def setup_inputs(seed: int = 0) -> dict:
    key = jax.random.key(seed)
    ks = jax.random.split(key, 16)
    f32 = jnp.float32
    nrm = lambda k, shape, s: (jax.random.normal(k, shape, f32) * s).astype(f32)
    return {
        "x_prompt": nrm(ks[0], (BATCH, SEQ, D_MODEL), 1.0),
        "x_sample": nrm(ks[1], (DEC_BATCH, DEC_SEQ, D_MODEL), 1.0),
        "norm_g": 1.0 + nrm(ks[2], (DEPTH, D_MODEL), 0.1),
        "w_in": nrm(ks[3], (DEPTH, D_MODEL, IN_COLS), D_MODEL ** -0.5),
        "qk_gain_a": 1.0 + nrm(ks[4], (DEPTH, 2, HEAD_DIM), 0.1),
        "lambda_a": nrm(ks[5], (DEPTH, 4, HEAD_DIM), 0.1),
        "subln_g_a": 1.0 + nrm(ks[6], (DEPTH, 2 * HEAD_DIM), 0.1),
        "qk_gain_b": 1.0 + nrm(ks[7], (DEPTH, 2, HEAD_DIM), 0.1),
        "rpb_b": nrm(ks[8], (DEPTH, H_B, 2 * MAX_KH - 1, 2 * KW - 1), 0.5),
        "qk_gain_c": 1.0 + nrm(ks[9], (DEPTH, 2, HEAD_DIM), 0.1),
        "sink_c": nrm(ks[10], (DEPTH, H_C), 1.0),
        "w_proj_a": nrm(ks[11], (DEPTH, W_A, D_MODEL), W_A ** -0.5),
        "w_proj_b": nrm(ks[12], (DEPTH, W_B, D_MODEL), W_B ** -0.5),
        "w_proj_c": nrm(ks[13], (DEPTH, W_C, D_MODEL), W_C ** -0.5),
        "w_out": nrm(ks[14], (DEPTH, D_MODEL, D_MODEL), D_MODEL ** -0.5),
    }


def reference(x_prompt, x_sample, norm_g, w_in, qk_gain_a, lambda_a, subln_g_a, qk_gain_b, rpb_b,
              qk_gain_c, sink_c, w_proj_a, w_proj_b, w_proj_c, w_out):
    y_prompt = trunk(x_prompt, norm_g, w_in, qk_gain_a, lambda_a, subln_g_a, qk_gain_b, rpb_b,
                     qk_gain_c, sink_c, w_proj_a, w_proj_b, w_proj_c, w_out)
    y_sample = trunk(x_sample, norm_g, w_in, qk_gain_a, lambda_a, subln_g_a, qk_gain_b, rpb_b,
                     qk_gain_c, sink_c, w_proj_a, w_proj_b, w_proj_c, w_out)
    return (y_prompt, y_sample)
```

```cpp
#include <hip/hip_runtime.h>
#include <hip/hip_cooperative_groups.h>
#include <cstdio>
#include <cstdint>
namespace cg = cooperative_groups;

#define LAS __attribute__((address_space(3)))
typedef LAS unsigned char* LASB;
typedef unsigned short bf16_t;
typedef short bf16x8 __attribute__((ext_vector_type(8)));
typedef short s16x4 __attribute__((ext_vector_type(4)));
typedef float f32x4 __attribute__((ext_vector_type(4)));
typedef float f32x2 __attribute__((ext_vector_type(2)));
typedef float f32x16 __attribute__((ext_vector_type(16)));
typedef unsigned u32x4 __attribute__((ext_vector_type(4)));
typedef unsigned u32x2 __attribute__((ext_vector_type(2)));
typedef __bf16 bf16x2_t __attribute__((ext_vector_type(2)));

constexpr int DM = 1024, LDP = 8448, NTOK_PROMPT = 65536, NTOK = 98304, T_PROMPT = 4096, T_SAMPLE = 16384;
constexpr int QA = 0, KA = 512, VA = 1024, ZA = 1536, QB = 2048, KB = 2560, VB = 3072, ZB = 3584, QC = 4096, KC = 4608, VC = 4736, ZC = 4864, GA = 5376;
constexpr float EPS = 1e-6f, LOG2E = 1.4426950408889634f, QS = 0.125f * 1.4426950408889634f;
constexpr int NTHREADS = 512, NWAVES = 8;
constexpr int LDS_BYTES = 157696, WSCR_OFF = 147456, TAB_OFF = 148480;

__device__ __forceinline__ unsigned cvtpk(float lo, float hi) { f32x2 v = {lo, hi}; bf16x2_t b = __builtin_convertvector(v, bf16x2_t); return __builtin_bit_cast(unsigned, b); }
__device__ __forceinline__ float bf2f(unsigned short u) { return __uint_as_float(((unsigned)u) << 16); }
__device__ __forceinline__ float wave_sum(float v) {
#pragma unroll
    for (int o = 1; o < 64; o <<= 1) v += __shfl_xor(v, o);
    return v;
}

namespace pg8 {
constexpr int BM = 256, BK = 64, HALF = 128, HTB = HALF * BK * 2, STAGE_BYTES = 8 * HTB, NXCD = 8, WGM = 8;
__host__ __device__ __forceinline__ int lds_byte(int r, int c) { const int st = (r >> 4) * 2 + (c >> 5), rr = r & 15, cc = c & 31, ob = rr * 64 + cc * 2; return st * 1024 + (ob ^ (((ob >> 9) & 1) << 5)); }
__host__ __device__ __forceinline__ void stage_rc(int b, int& R, int& C) { const int st = b / 1024, sb = b % 1024, swz = sb ^ (((sb >> 9) & 1) << 5); R = (st >> 1) * 16 + swz / 64; C = (st & 1) * 32 + (swz % 64) / 2; }
__host__ __device__ __forceinline__ int perm32(int rho) { const int n = rho >> 4, i = rho & 15; return 8 * (i >> 2) + 4 * n + (i & 3); }

struct Unit { int pm, pn, kind; };
struct Gemm { const bf16_t* A; const bf16_t* Bt; int M, N, K; size_t sA, sB; };

template <int N, int NK> struct StaticOrder {
    int nwg8, G, c;
    __device__ __forceinline__ void init(int M, int G_, int c_) { nwg8 = (M / BM) * (N / BM) / NXCD; G = G_; c = c_; }
    __device__ __forceinline__ bool next(int i, Unit& u) const {
        constexpr int nN = N / BM, nig = WGM * nN;
        const int ti = i / NK; u.kind = i - ti * NK;
        const int L = ti * G + c; if (L >= nwg8 * NXCD) return false;
        const int wgid = (L & (NXCD - 1)) * nwg8 + (L >> 3);
        const int gid = wgid / nig, rem = wgid - gid * nig;
        u.pm = gid * WGM + (rem & (WGM - 1)); u.pn = rem / WGM; return true;
    }
};

struct EpiInProj {
    static constexpr bool PERM = true, CHAIN = false;
    bf16_t* P; const float* ga; const float* gb; const float* gc;
    bf16_t* KV; int MC;
    __device__ __forceinline__ void operator()(const f32x4 (&acc)[2][2][4][2], const Unit& u, int wr, int wc, int fr, int fq) const {
        const int hg = u.pn * 4 + wc;
        int mode; const float* gp = ga; float qs = 1.f;
        if (hg < 8) { mode = 1; gp = ga; qs = QS; }
        else if (hg < 16) { mode = 1; gp = ga + 64; }
        else if (hg < 24) mode = 0;
        else if (hg < 32) mode = 2;
        else if (hg < 40) { mode = 1; gp = gb; qs = QS; }
        else if (hg < 48) { mode = 1; gp = gb + 64; }
        else if (hg < 56) mode = 0;
        else if (hg < 64) mode = 2;
        else if (hg < 72) { mode = 1; gp = gc; qs = QS; }
        else if (hg < 74) { mode = 1; gp = gc + 64; }
        else if (hg < 76) mode = 0;
        else if (hg < 84) mode = 2;
        else mode = 3;
        float gv[2][8];
#pragma unroll
        for (int bj = 0; bj < 2; ++bj)
#pragma unroll
            for (int j = 0; j < 8; ++j) gv[bj][j] = (mode == 1) ? gp[32 * bj + 8 * fq + j] * qs : 1.f;
        const int col0 = hg * 64 + 8 * fq;
        size_t kvo = 0; int kvs = 0;
        if (hg >= 8 && hg < 16) { kvs = 256; kvo = (size_t)((hg - 8) >> 1) * MC * 256 + ((hg - 8) & 1) * 64; }
        else if (hg >= 16 && hg < 24) { kvs = 256; kvo = (size_t)((hg - 16) >> 1) * MC * 256 + 128 + ((hg - 16) & 1) * 64; }
        else if (hg >= 40 && hg < 48) { kvs = 512; kvo = (size_t)4 * MC * 256 + (size_t)((hg - 40) >> 2) * MC * 512 + ((hg - 40) & 3) * 64; }
        else if (hg >= 48 && hg < 56) { kvs = 512; kvo = (size_t)4 * MC * 256 + (size_t)((hg - 48) >> 2) * MC * 512 + 256 + ((hg - 48) & 3) * 64; }
        else if (hg >= 72 && hg < 74) { kvs = 128; kvo = (size_t)4 * MC * 256 + (size_t)2 * MC * 512 + (size_t)(hg - 72) * MC * 128; }
        else if (hg >= 74 && hg < 76) { kvs = 128; kvo = (size_t)4 * MC * 256 + (size_t)2 * MC * 512 + (size_t)(hg - 74) * MC * 128 + 64; }
#pragma unroll
        for (int ai = 0; ai < 2; ++ai)
#pragma unroll
            for (int m = 0; m < 4; ++m) {
                const int row = u.pm * BM + ai * HALF + wr * 64 + m * 16 + fr;
                float v[2][8];
#pragma unroll
                for (int bj = 0; bj < 2; ++bj)
#pragma unroll
                    for (int n = 0; n < 2; ++n)
#pragma unroll
                        for (int e = 0; e < 4; ++e) v[bj][4 * n + e] = acc[ai][bj][m][n][e];
                if (mode == 1) {
                    float ss = 0.f;
#pragma unroll
                    for (int bj = 0; bj < 2; ++bj)
#pragma unroll
                        for (int j = 0; j < 8; ++j) ss += v[bj][j] * v[bj][j];
                    ss += __shfl_xor(ss, 16); ss += __shfl_xor(ss, 32);
                    const float rstd = 1.0f / sqrtf(ss * (1.f / 64.f) + EPS);
#pragma unroll
                    for (int bj = 0; bj < 2; ++bj)
#pragma unroll
                        for (int j = 0; j < 8; ++j) v[bj][j] = v[bj][j] * rstd * gv[bj][j];
                } else if (mode == 2) {
#pragma unroll
                    for (int bj = 0; bj < 2; ++bj)
#pragma unroll
                        for (int j = 0; j < 8; ++j) v[bj][j] = v[bj][j] * __builtin_amdgcn_rcpf(1.f + __expf(-v[bj][j]));
                } else if (mode == 3) {
#pragma unroll
                    for (int bj = 0; bj < 2; ++bj)
#pragma unroll
                        for (int j = 0; j < 8; ++j) v[bj][j] = __builtin_amdgcn_rcpf(1.f + __expf(-v[bj][j]));
                }
                bf16_t* rowp = kvs ? KV + kvo + (size_t)row * kvs + 8 * fq : P + (size_t)row * LDP + col0;
#pragma unroll
                for (int bj = 0; bj < 2; ++bj) {
                    u32x4 w; w.x = cvtpk(v[bj][0], v[bj][1]); w.y = cvtpk(v[bj][2], v[bj][3]); w.z = cvtpk(v[bj][4], v[bj][5]); w.w = cvtpk(v[bj][6], v[bj][7]);
                    *(u32x4*)(rowp + 32 * bj) = w;
                }
            }
    }
};
struct EpiProjGate {
    static constexpr bool PERM = true, CHAIN = true;
    const bf16_t* P; bf16_t* MB;
    __device__ __forceinline__ void operator()(f32x4 (&acc)[2][2][4][2], const Unit& u, int wr, int wc, int fr, int fq) const {
        const int c0 = u.pn * BM + wc * 32 + 8 * fq;
        const int knext = u.kind < 2 ? u.kind + 1 : 2;
#pragma unroll
        for (int ai = 0; ai < 2; ++ai)
#pragma unroll
            for (int mp = 0; mp < 2; ++mp) {
                bf16x8 g[2][2], gn[2][2];
#pragma unroll
                for (int mm = 0; mm < 2; ++mm)
#pragma unroll
                    for (int bj = 0; bj < 2; ++bj) {
                        const int row = u.pm * BM + ai * HALF + wr * 64 + (2 * mp + mm) * 16 + fr, c = c0 + bj * HALF;
                        g[mm][bj] = *(const bf16x8*)(P + (size_t)row * LDP + GA + u.kind * 1024 + c);
                        gn[mm][bj] = *(const bf16x8*)(P + (size_t)row * LDP + GA + knext * 1024 + c);
                    }
                asm volatile("" ::: "memory");
                if (u.kind < 2) {
#pragma unroll
                    for (int mm = 0; mm < 2; ++mm)
#pragma unroll
                        for (int bj = 0; bj < 2; ++bj)
#pragma unroll
                            for (int n = 0; n < 2; ++n)
#pragma unroll
                                for (int e = 0; e < 4; ++e)
                                    acc[ai][bj][2 * mp + mm][n][e] *= bf2f((unsigned short)g[mm][bj][4 * n + e]) * __builtin_amdgcn_rcpf(fmaxf(bf2f((unsigned short)gn[mm][bj][4 * n + e]), 1e-30f));
                } else {
#pragma unroll
                    for (int mm = 0; mm < 2; ++mm)
#pragma unroll
                        for (int bj = 0; bj < 2; ++bj) {
                            const int row = u.pm * BM + ai * HALF + wr * 64 + (2 * mp + mm) * 16 + fr, c = c0 + bj * HALF;
                            float v[8];
#pragma unroll
                            for (int n = 0; n < 2; ++n)
#pragma unroll
                                for (int e = 0; e < 4; ++e) v[4 * n + e] = acc[ai][bj][2 * mp + mm][n][e] * bf2f((unsigned short)g[mm][bj][4 * n + e]);
                            u32x4 w; w.x = cvtpk(v[0], v[1]); w.y = cvtpk(v[2], v[3]); w.z = cvtpk(v[4], v[5]); w.w = cvtpk(v[6], v[7]);
                            *(u32x4*)(MB + (size_t)row * DM + c) = w;
                        }
                }
                asm volatile("" ::: "memory");
            }
    }
};
struct EpiResid {
    static constexpr bool PERM = false, CHAIN = false;
    const float* xin; float* out;
    __device__ __forceinline__ void operator()(const f32x4 (&acc)[2][2][4][2], const Unit& u, int wr, int wc, int fr, int fq) const {
        const int c0 = u.pn * BM + wc * 32 + 4 * fq;
#pragma unroll
        for (int ai = 0; ai < 2; ++ai)
#pragma unroll
            for (int mp = 0; mp < 2; ++mp) {
                f32x4 b[2][2][2];
#pragma unroll
                for (int mm = 0; mm < 2; ++mm) { const size_t off = (size_t)(u.pm * BM + ai * HALF + wr * 64 + (2 * mp + mm) * 16 + fr) * DM + c0;
#pragma unroll
                    for (int bj = 0; bj < 2; ++bj)
#pragma unroll
                        for (int n = 0; n < 2; ++n) b[mm][bj][n] = *(const f32x4*)(xin + off + bj * HALF + n * 16); }
                asm volatile("" ::: "memory");
#pragma unroll
                for (int mm = 0; mm < 2; ++mm) { const size_t off = (size_t)(u.pm * BM + ai * HALF + wr * 64 + (2 * mp + mm) * 16 + fr) * DM + c0;
#pragma unroll
                    for (int bj = 0; bj < 2; ++bj)
#pragma unroll
                        for (int n = 0; n < 2; ++n) *(f32x4*)(out + off + bj * HALF + n * 16) = b[mm][bj][n] + acc[ai][bj][2 * mp + mm][n]; }
                asm volatile("" ::: "memory");
            }
    }
};

template <class Epi, class Sched, int K, int NK>
__device__ __forceinline__ void gemm_phase(LASB lds, const Gemm g, const Sched& S, const Epi& E) {
    int tid = threadIdx.x; asm volatile("" : "+v"(tid));
    const int wid = __builtin_amdgcn_readfirstlane(tid >> 6), lane = tid & 63, wr = wid >> 2, wc = wid & 3, fr = lane & 15, fq = lane >> 4;
    constexpr int nt = K / BK;
    unsigned voffA[2], voffB[2];
#pragma unroll
    for (int i = 0; i < 2; ++i) { int R, C; stage_rc(tid * 16 + i * 8192, R, C); const int Rb = Epi::PERM ? ((R & ~31) + perm32(R & 31)) : R;
        voffA[i] = (unsigned)(R * K + C) * 2u; voffB[i] = (unsigned)(Rb * K + C) * 2u; }
    constexpr size_t kstep = (size_t)(BK * 2);
    constexpr size_t hstep = (size_t)HALF * K * 2;
    constexpr size_t tstep = 2 * hstep;
    const unsigned ldsw = (unsigned)wid * 1024u;
    const int aoff = lds_byte(wr * 64 + fr, fq * 8), boff = lds_byte(wc * 32 + fr, fq * 8);
#define PG8_SA(b, h) (((b) * 2 + (h)) * HTB)
#define PG8_SB(b, h) ((4 + (b) * 2 + (h)) * HTB)
#define PG8_STAGE(bufoff, gbase, voff) do { _Pragma("unroll") for (int _i = 0; _i < 2; ++_i) \
        __builtin_amdgcn_global_load_lds((const unsigned*)((const char*)(gbase) + (voff)[_i]), (LAS unsigned*)(lds + (bufoff) + ldsw + _i * 8192), 16, 0, 0); } while (0)
#define PG8_LDA(dst, b, h) do { _Pragma("unroll") for (int m = 0; m < 4; ++m) _Pragma("unroll") for (int k = 0; k < 2; ++k) dst[m][k] = *(const LAS bf16x8*)(lds + PG8_SA(b, h) + aoff + m * 2048 + k * 1024); } while (0)
#define PG8_LDB(dst, b, h) do { _Pragma("unroll") for (int n = 0; n < 2; ++n) _Pragma("unroll") for (int k = 0; k < 2; ++k) dst[n][k] = *(const LAS bf16x8*)(lds + PG8_SB(b, h) + boff + n * 2048 + k * 1024); } while (0)
#define PG8_MMA(ai, bj, At, Bt) do { __builtin_amdgcn_s_setprio(1); _Pragma("unroll") for (int m = 0; m < 4; ++m) _Pragma("unroll") for (int n = 0; n < 2; ++n) _Pragma("unroll") for (int k = 0; k < 2; ++k) \
        acc[ai][bj][m][n] = __builtin_amdgcn_mfma_f32_16x16x32_bf16(Bt[n][k], At[m][k], acc[ai][bj][m][n], 0, 0, 0); __builtin_amdgcn_s_setprio(0); } while (0)
#define PG8_WAIT_V(n) asm volatile("s_waitcnt vmcnt(" #n ")" ::: "memory")
#define PG8_WAIT_L(n) asm volatile("s_waitcnt lgkmcnt(" #n ")" ::: "memory")
#define PG8_BAR __builtin_amdgcn_s_barrier()
#define PG8_SCHED __builtin_amdgcn_sched_barrier(0)
    Unit cur, nxt; int ui = 0;
    if (!S.next(0, cur)) return;
    f32x4 acc[2][2][4][2];
#pragma unroll
    for (int a = 0; a < 2; ++a)
#pragma unroll
        for (int b = 0; b < 2; ++b)
#pragma unroll
            for (int m = 0; m < 4; ++m)
#pragma unroll
                for (int n = 0; n < 2; ++n) acc[a][b][m][n] = (f32x4){0.f, 0.f, 0.f, 0.f};
    bf16x8 At[4][2], B0[2][2], B1[2][2];
    const char* cA = (const char*)(g.A + (NK > 1 ? (size_t)cur.kind * g.sA : 0)) + (size_t)cur.pm * tstep; const char* cB = (const char*)(g.Bt + (NK > 1 ? (size_t)cur.kind * g.sB : 0)) + (size_t)cur.pn * tstep;
    PG8_STAGE(PG8_SB(0, 0), cB, voffB); PG8_STAGE(PG8_SB(0, 1), cB + hstep, voffB); PG8_STAGE(PG8_SA(0, 0), cA, voffA); PG8_STAGE(PG8_SA(0, 1), cA + hstep, voffA);
    if (wr == 1) PG8_BAR;
    PG8_WAIT_V(2); PG8_BAR;
    PG8_STAGE(PG8_SB(1, 0), cB + kstep, voffB); PG8_STAGE(PG8_SA(1, 0), cA + kstep, voffA); PG8_STAGE(PG8_SB(1, 1), cB + hstep + kstep, voffB);
    PG8_WAIT_V(6); PG8_BAR;
    for (;;) {
        const bool has_next = S.next(ui + 1, nxt);
        const char* nA = has_next ? (const char*)(g.A + (NK > 1 ? (size_t)nxt.kind * g.sA : 0)) + (size_t)nxt.pm * tstep : cA;
        const char* nB = has_next ? (const char*)(g.Bt + (NK > 1 ? (size_t)nxt.kind * g.sB : 0)) + (size_t)nxt.pn * tstep : cB;
        for (int t = 0; t < nt; t += 2) {
            const bool last = (t == nt - 2);
            const char* a1 = cA + (size_t)(t + 1) * kstep;
            const char* a2 = last ? nA : cA + (size_t)(t + 2) * kstep; const char* b2 = last ? nB : cB + (size_t)(t + 2) * kstep;
            const char* a3 = a2 + kstep; const char* b3 = b2 + kstep;
            PG8_LDB(B0, 0, 0); PG8_LDB(B1, 0, 1); PG8_SCHED; PG8_LDA(At, 0, 0); PG8_STAGE(PG8_SA(1, 1), a1 + hstep, voffA);
            PG8_WAIT_V(8); PG8_WAIT_L(0); PG8_BAR; PG8_MMA(0, 0, At, B0); PG8_MMA(0, 1, At, B1); PG8_BAR; PG8_SCHED;
            PG8_LDA(At, 0, 1); PG8_STAGE(PG8_SB(0, 0), b2, voffB); PG8_STAGE(PG8_SB(0, 1), b2 + hstep, voffB); PG8_STAGE(PG8_SA(0, 0), a2, voffA);
            PG8_WAIT_V(8); PG8_WAIT_L(0); PG8_BAR; PG8_MMA(1, 0, At, B0); PG8_MMA(1, 1, At, B1); PG8_BAR; PG8_SCHED;
            PG8_LDB(B0, 1, 0); PG8_LDB(B1, 1, 1); PG8_SCHED; PG8_LDA(At, 1, 0); PG8_STAGE(PG8_SA(0, 1), a2 + hstep, voffA);
            PG8_WAIT_V(8); PG8_WAIT_L(0); PG8_BAR; PG8_MMA(0, 0, At, B0); PG8_MMA(0, 1, At, B1); PG8_BAR; PG8_SCHED;
            PG8_LDA(At, 1, 1); PG8_STAGE(PG8_SB(1, 0), b3, voffB); PG8_STAGE(PG8_SB(1, 1), b3 + hstep, voffB); PG8_STAGE(PG8_SA(1, 0), a3, voffA);
            PG8_WAIT_V(8); PG8_WAIT_L(0); PG8_BAR; PG8_MMA(1, 0, At, B0); PG8_MMA(1, 1, At, B1); PG8_BAR; PG8_SCHED;
        }
        if (wr == 0) PG8_BAR;
        E(acc, cur, wr, wc, fr, fq);
        if (!has_next) break;
        if (!(Epi::CHAIN && nxt.kind != 0))
#pragma unroll
        for (int a = 0; a < 2; ++a)
#pragma unroll
            for (int b = 0; b < 2; ++b)
#pragma unroll
                for (int m = 0; m < 4; ++m)
#pragma unroll
                    for (int n = 0; n < 2; ++n) acc[a][b][m][n] = (f32x4){0.f, 0.f, 0.f, 0.f};
        cur = nxt; cA = nA; cB = nB; ++ui;
        if (wr == 1) PG8_BAR;
    }
    PG8_WAIT_V(0);
    PG8_BAR;
#undef PG8_SA
#undef PG8_SB
#undef PG8_STAGE
#undef PG8_LDA
#undef PG8_LDB
#undef PG8_MMA
#undef PG8_WAIT_V
#undef PG8_WAIT_L
#undef PG8_BAR
#undef PG8_SCHED
}
}

#define MFMA32(a, b, c) __builtin_amdgcn_mfma_f32_32x32x16_bf16((a), (b), (c), 0, 0, 0)
#define SCHED_FENCE() __builtin_amdgcn_sched_barrier(0)
typedef short v4i16_t __attribute__((ext_vector_type(4)));
__device__ __forceinline__ s16x4 tr_read(LASB p) { return __builtin_bit_cast(s16x4, __builtin_amdgcn_ds_read_tr16_b64_v4i16((LAS v4i16_t*)p)); }
__device__ __forceinline__ int crow(int i, int h) { return (i & 3) + 8 * (i >> 2) + 4 * h; }
template <int DV, int KW, int VW, int KT, int RS, class BF>
__device__ __forceinline__ void flash(LASB lds, const bf16_t* kbase, const bf16_t* vbase, int nt, const bf16x8 (&qf)[4], int kcol, int vcol, BF& bf,
                                      f32x16 (&o)[DV / 32], float& m, float& l, int tid, int lane) {
    constexpr int KSTR = KW * 2 + 16, VSTR = VW * 2 + 64, KBY = KT * KSTR, BUF = KT * KSTR + KT * VSTR;
    constexpr int KPR = KW / 8, VPR = VW / 8, NPK = KT * KPR / NTHREADS, NPV = KT * VPR / NTHREADS, NKT = KT / 32, NDB = DV / 32;
    static_assert(NPK >= 1 && NPV >= 1 && 2 * BUF <= WSCR_OFF, "flash geometry");
    const int r = lane & 31, h = lane >> 5;
    u32x4 kr[NPK], vr[NPV];
    int kgo[NPK], klo[NPK], vgo[NPV], vlo[NPV];
#pragma unroll
    for (int i = 0; i < NPK; ++i) { const int pid = tid + NTHREADS * i, row = pid / KPR, cp = pid % KPR; kgo[i] = row * RS + cp * 8; klo[i] = row * KSTR + cp * 16; }
#pragma unroll
    for (int i = 0; i < NPV; ++i) { const int pid = tid + NTHREADS * i, row = pid / VPR, cp = pid % VPR; vgo[i] = row * RS + cp * 8; vlo[i] = KBY + row * VSTR + cp * 16; }
    const int koff = r * KSTR + (kcol + 8 * h) * 2;
    const int voff = KBY + (4 * h + ((lane & 15) >> 2)) * VSTR + (vcol + 16 * ((lane >> 4) & 1) + 4 * (lane & 3)) * 2;
#pragma unroll
    for (int i = 0; i < NPK; ++i) kr[i] = *(const u32x4*)(kbase + kgo[i]);
#pragma unroll
    for (int i = 0; i < NPV; ++i) vr[i] = *(const u32x4*)(vbase + vgo[i]);
#pragma unroll
    for (int i = 0; i < NPK; ++i) *(LAS u32x4*)(lds + klo[i]) = kr[i];
#pragma unroll
    for (int i = 0; i < NPV; ++i) *(LAS u32x4*)(lds + vlo[i]) = vr[i];
    __syncthreads();
    for (int t = 0; t < nt; ++t) {
        const LASB buf = lds + (t & 1) * BUF;
        if (t + 1 < nt) {
            const bf16_t* kb = kbase + (size_t)(t + 1) * KT * RS; const bf16_t* vb = vbase + (size_t)(t + 1) * KT * RS;
#pragma unroll
            for (int i = 0; i < NPK; ++i) kr[i] = *(const u32x4*)(kb + kgo[i]);
#pragma unroll
            for (int i = 0; i < NPV; ++i) vr[i] = *(const u32x4*)(vb + vgo[i]);
        }
        bf.set_tile(t);
        bf16x8 kf[NKT][2];
#pragma unroll
        for (int kt = 0; kt < NKT; ++kt)
#pragma unroll
            for (int sd = 0; sd < 2; ++sd) kf[kt][sd] = *(const LAS bf16x8*)(buf + koff + kt * 32 * KSTR + sd * 32);
        f32x16 S[NKT];
#pragma unroll
        for (int kt = 0; kt < NKT; ++kt) {
            if constexpr (BF::FIXM) S[kt] = MFMA32(bf.abias[kt], bf.bbias, (f32x16){});
            else S[kt] = (f32x16){};
        }
        SCHED_FENCE();
        bf16x8 kg[NKT][2];
#pragma unroll
        for (int kt = 0; kt < NKT; ++kt)
#pragma unroll
            for (int sd = 0; sd < 2; ++sd) kg[kt][sd] = *(const LAS bf16x8*)(buf + koff + kt * 32 * KSTR + (sd + 2) * 32);
#pragma unroll
        for (int sd = 0; sd < 2; ++sd)
#pragma unroll
            for (int kt = 0; kt < NKT; ++kt) S[kt] = MFMA32(kf[kt][sd], qf[sd], S[kt]);
        SCHED_FENCE();
        bf16x8 vf[2][NDB];
#pragma unroll
        for (int db = 0; db < NDB; ++db) { const LASB vp = buf + voff + db * 64; const s16x4 lo = tr_read(vp), hi = tr_read(vp + 8 * VSTR); vf[0][db] = __builtin_shufflevector(lo, hi, 0, 1, 2, 3, 4, 5, 6, 7); }
#pragma unroll
        for (int sd = 0; sd < 2; ++sd)
#pragma unroll
            for (int kt = 0; kt < NKT; ++kt) S[kt] = MFMA32(kg[kt][sd], qf[sd + 2], S[kt]);
        SCHED_FENCE();
        f32x2 rs2 = {0.f, 0.f}; float rsa = 0.f;
        if (BF::FIXM && bf.fixm) {
            if (bf.diag) {
#pragma unroll
                for (int kt = 0; kt < NKT; ++kt)
#pragma unroll
                    for (int i = 0; i < 16; ++i) S[kt][i] = bf.apply(S[kt][i], kt * 32 + (i & 3) + 8 * (i >> 2));
            }
#pragma unroll
            for (int kt = 0; kt < NKT; ++kt)
#pragma unroll
                for (int i = 0; i < 16; ++i) { const float p0 = __builtin_amdgcn_exp2f(S[kt][i]); S[kt][i] = p0; rsa += p0; asm volatile("" : "+v"(rsa)); }
            l += rsa;
        } else {
#define FLASH_LIVE(HS, kt, i) ((HS) < 0 || ((HS) == 0 ? ((kt) == 0 || ((i) >> 2) == 0) : ((kt) == NKT - 1 || ((i) >> 2) == 3)))
#define FLASH_SOFTMAX(HS) do { \
            float mx = -INFINITY; \
            _Pragma("unroll") for (int kt = 0; kt < NKT; ++kt) \
            _Pragma("unroll") for (int i = 0; i < 16; ++i) if (FLASH_LIVE(HS, kt, i)) { const float v = (!BF::FIXM || bf.diag) ? bf.apply(S[kt][i], kt * 32 + (i & 3) + 8 * (i >> 2)) : S[kt][i]; S[kt][i] = v; mx = fmaxf(mx, v); } \
            mx = fmaxf(mx, __shfl_xor(mx, 32)); \
            alpha = 1.f; \
            if (__any(mx > m + 8.f)) {            \
                const float mnew = (mx > m + 8.f) ? mx : m, mu_ = (mnew == -INFINITY) ? 0.f : mnew; \
                alpha = __builtin_amdgcn_exp2f(m - mu_); \
                m = mnew; } \
            muse = (m == -INFINITY) ? 0.f : m; \
            _Pragma("unroll") for (int kt = 0; kt < NKT; ++kt) \
            _Pragma("unroll") for (int i = 0; i < 16; i += 2) { \
                if (FLASH_LIVE(HS, kt, i)) { const float p0 = __builtin_amdgcn_exp2f(S[kt][i] - muse), p1 = __builtin_amdgcn_exp2f(S[kt][i + 1] - muse); S[kt][i] = p0; S[kt][i + 1] = p1; rs2 += (f32x2){p0, p1}; } \
                else { S[kt][i] = 0.f; S[kt][i + 1] = 0.f; } } } while (0)
            float muse, alpha;
            if constexpr (BF::HALFMASK) { if (bf.hsel == 0) FLASH_SOFTMAX(0); else FLASH_SOFTMAX(1); }
            else FLASH_SOFTMAX(-1);
#undef FLASH_SOFTMAX
#undef FLASH_LIVE
            l = l * alpha + (rs2.x + rs2.y);
            if (__any(alpha != 1.f)) {
#pragma unroll
                for (int db = 0; db < NDB; ++db)
#pragma unroll
                    for (int i = 0; i < 16; ++i) o[db][i] *= alpha;
            }
        }
        bf16x8 pf[NKT][2];
#pragma unroll
        for (int kt = 0; kt < NKT; ++kt)
#pragma unroll
            for (int s = 0; s < 2; ++s) {
                u32x4 w; w.x = cvtpk(S[kt][8 * s + 0], S[kt][8 * s + 1]); w.y = cvtpk(S[kt][8 * s + 2], S[kt][8 * s + 3]);
                w.z = cvtpk(S[kt][8 * s + 4], S[kt][8 * s + 5]); w.w = cvtpk(S[kt][8 * s + 6], S[kt][8 * s + 7]);
                pf[kt][s] = __builtin_bit_cast(bf16x8, w);
            }
        SCHED_FENCE();
#pragma unroll
        for (int st = 0; st < 2 * NKT; ++st) {
            if (st + 1 < 2 * NKT) {
#pragma unroll
                for (int db = 0; db < NDB; ++db) { const LASB vp = buf + voff + (16 * (st + 1)) * VSTR + db * 64; const s16x4 lo = tr_read(vp), hi = tr_read(vp + 8 * VSTR); vf[(st + 1) & 1][db] = __builtin_shufflevector(lo, hi, 0, 1, 2, 3, 4, 5, 6, 7); }
            }
#pragma unroll
            for (int db = 0; db < NDB; ++db) o[db] = MFMA32(vf[st & 1][db], pf[st >> 1][st & 1], o[db]);
            SCHED_FENCE();
        }
        if (t + 1 < nt) {
            const LASB nb = lds + ((t + 1) & 1) * BUF;
#pragma unroll
            for (int i = 0; i < NPK; ++i) *(LAS u32x4*)(nb + klo[i]) = kr[i];
#pragma unroll
            for (int i = 0; i < NPV; ++i) *(LAS u32x4*)(nb + vlo[i]) = vr[i];
        }
        __syncthreads();
    }
}

__device__ __forceinline__ float bf_round(float x) { return __uint_as_float(cvtpk(x, 0.f) << 16); }
struct BiasA {
    static constexpr bool FIXM = true, HALFMASK = false;
    bool fixm; float sl2; int q; float dqh; float M;
    int qrel, rlane, hl; bool diag; float s_hi, s_mid, s_lo; bf16x8 abias[2], bbias;
    __device__ __forceinline__ void init_mfma(int qrel_, int r, int h) {
        qrel = qrel_; rlane = r; hl = h; diag = false;
        s_hi = bf_round(sl2); s_mid = bf_round(sl2 - s_hi); s_lo = bf_round(sl2 - s_hi - s_mid);
#pragma unroll
        for (int kt = 0; kt < 2; ++kt) { const float j = (float)(kt * 32 + r); u32x4 w;
            if (h == 0) { w.x = cvtpk(j, j); w.y = cvtpk(j, s_hi); w.z = cvtpk(s_mid, s_lo); w.w = cvtpk(1.f, 1.f); } else { w.x = cvtpk(1.f, 0.f); w.y = 0u; w.z = 0u; w.w = 0u; }
            abias[kt] = __builtin_bit_cast(bf16x8, w); }
        bbias = abias[0];
    }
    __device__ __forceinline__ void set_tile(int t) {
        dqh = (float)(q - 64 * t);
        {
            const int dd = qrel - 64 * t;
            diag = (dd == 0) || (dd == 32);
            const float sg = diag ? 0.f : (dd > 0 ? 1.f : -1.f);
            const float c = diag ? -M : -sl2 * fabsf((float)dd) - M;
            const float c_hi = bf_round(c), c_mid = bf_round(c - c_hi), c_lo = bf_round(c - c_hi - c_mid);
            const float nr = -sg * (float)rlane;
            u32x4 w;
            if (hl == 0) { w.x = cvtpk(sg * s_hi, sg * s_mid); w.y = cvtpk(sg * s_lo, nr); w.z = cvtpk(nr, nr); w.w = cvtpk(c_hi, c_mid); } else { w.x = cvtpk(c_lo, 0.f); w.y = 0u; w.z = 0u; w.w = 0u; }
            bbias = __builtin_bit_cast(bf16x8, w);
        }
    }
    __device__ __forceinline__ float apply(float s, int c) const { const float d = dqh - (float)c; return __builtin_fmaf(-sl2, __builtin_fabsf(d), s); }
};
struct BiasC {
    static constexpr bool FIXM = false, fixm = false, diag = true, HALFMASK = false; static constexpr float M = 0.f;
    float sl2; int q; float dqh;
    __device__ __forceinline__ void set_tile(int t) { dqh = (float)(q - 64 * t); }
    __device__ __forceinline__ float apply(float s, int c) const { const float d = __builtin_fabsf(dqh - (float)c); return d <= 128.f ? __builtin_fmaf(-sl2, d, s) : -INFINITY; }
};
struct BiasB {
    static constexpr bool FIXM = false, fixm = false, diag = true, HALFMASK = true; static constexpr float M = 0.f;
    int hsel;
    const LAS float* tabh; const LAS float* trow; int qc, cs, kc0, rs_minus_gr, h4;
    __device__ __forceinline__ void set_tile(int t) { trow = tabh + (rs_minus_gr + t + 7) * 31; kc0 = h4; }
    __device__ __forceinline__ float apply(float s, int c) const {
        const int kc = kc0 + c; const bool valid = (unsigned)(kc - cs) < 16u; const int idx = valid ? (kc - qc + 15) : 0;
        return valid ? s + trow[idx] : -INFINITY;
    }
};


#define XB_TMO      128
#define XB_XCNT(j)  (256  + 64 * (j))
#define XB_XSUB(j)  (1280 + 64 * (j))
#define XB_XGEN(j)  (2304 + 64 * (j))
#define XB_TOP      3328
#define XB_TOPGEN   3392
#define XCD_BAR_WORDS 3456
#define XB_SPIN_CAP (1u << 22)
__device__ __forceinline__ unsigned xb_ld(unsigned* p)              { return __hip_atomic_load(p, __ATOMIC_RELAXED, __HIP_MEMORY_SCOPE_AGENT); }
__device__ __forceinline__ unsigned xb_add(unsigned* p, unsigned v) { return __hip_atomic_fetch_add(p, v, __ATOMIC_RELAXED, __HIP_MEMORY_SCOPE_AGENT); }
__device__ __forceinline__ unsigned xb_xcc_id() { return (unsigned)__builtin_amdgcn_s_getreg((3 << 11) | 20) & 0xFu; }
#define XB_SPIN(cond, bar) do { unsigned _sp = 0; while (cond) { __builtin_amdgcn_s_sleep(1); \
    if ((++_sp & 255u) == 0u) { if (xb_ld(&(bar)[XB_TMO])) break; if (_sp > XB_SPIN_CAP) { atomicAdd(&(bar)[XB_TMO], 1u); break; } } } } while (0)
struct XcdBarrier { unsigned* bar; unsigned x; volatile LAS unsigned* st; };
__device__ __forceinline__ XcdBarrier xcd_barrier_post(unsigned* bar, volatile LAS unsigned* st) {
    XcdBarrier b; b.bar = bar; b.x = xb_xcc_id(); b.st = st;
    if (threadIdx.x == 0) (void)xb_add(&bar[XB_XCNT(b.x)], 1u);
    return b;
}
__device__ __forceinline__ void xcd_barrier_complete(unsigned* bar, unsigned x, unsigned& nloc, unsigned& nx) {
    const unsigned G = gridDim.x * gridDim.y * gridDim.z;
    unsigned sum, cnt, mine, sp = 0u;
    for (;;) {
        sum = 0u; cnt = 0u; mine = 0u;
#pragma unroll 1
        for (unsigned j = 0; j < 16; ++j) { const unsigned c = xb_ld(&bar[XB_XCNT(j)]); sum += c; cnt += (c > 0u) ? 1u : 0u; mine = (j == x) ? c : mine; }
        if (sum == G) break;
        __builtin_amdgcn_s_sleep(1);
        if ((++sp & 255u) == 0u) { if (xb_ld(&bar[XB_TMO])) break; if (sp > XB_SPIN_CAP) { atomicAdd(&bar[XB_TMO], 1u); break; } }
    }
    nloc = mine > 0u ? mine : 1u; nx = cnt > 0u ? cnt : 1u;
}
__device__ __forceinline__ void xcd_barrier(const XcdBarrier& b) {
    asm volatile("s_waitcnt vmcnt(0)" ::: "memory");
    __syncthreads();
    if (threadIdx.x == 0) {
        unsigned* bar = b.bar;
        __builtin_amdgcn_s_waitcnt(0);
        unsigned nloc = b.st[0], nx = b.st[1];
        if (nloc == 0u) { xcd_barrier_complete(bar, b.x, nloc, nx); b.st[0] = nloc; b.st[1] = nx; }
        const unsigned old = xb_add(&bar[XB_XSUB(b.x)], 1u);
        const unsigned gen = old / nloc;
        if (old + 1u == (gen + 1u) * nloc) {
            __builtin_amdgcn_fence(__ATOMIC_RELEASE, "agent");
            asm volatile("s_waitcnt vmcnt(0)" ::: "memory");
            const unsigned og = xb_add(&bar[XB_TOP], 1u);
            const unsigned tg = og / nx;
            if (og + 1u == (tg + 1u) * nx) xb_add(&bar[XB_TOPGEN], 1u);
            else XB_SPIN(xb_ld(&bar[XB_TOPGEN]) == tg, bar);
            __builtin_amdgcn_fence(__ATOMIC_ACQUIRE, "agent");
            xb_add(&bar[XB_XGEN(b.x)], 1u);
            asm volatile("s_waitcnt vmcnt(0)" ::: "memory");
        } else {
            XB_SPIN(xb_ld(&bar[XB_XGEN(b.x)]) == gen, bar);
            __builtin_amdgcn_fence(__ATOMIC_ACQUIRE, "agent");
            asm volatile("s_waitcnt vmcnt(0)" ::: "memory");
        }
    }
    __syncthreads();
}

struct Args {
    const float* x_prompt; const float* x_sample; const float* norm_g; const float* w_in; const float* qk_gain_a; const float* lambda_a; const float* subln_g_a;
    const float* qk_gain_b; const float* rpb_b; const float* qk_gain_c; const float* sink_c; const float* w_proj_a; const float* w_proj_b; const float* w_proj_c; const float* w_out;
    float* out; unsigned char* ws;
    unsigned long long off_wint, off_wpt, off_wot, off_h, off_p, off_og, off_kv;
    int MC, pad;
};

__device__ __forceinline__ void transpose_item(const float* W, int K, int N, bf16_t* WT, bool permute, LAS float* scr, int item, int lane) {
    const int nblk = N / 32, kb = item / nblk, nb = item % nblk, k0 = 64 * kb, n0 = 32 * nb;
#pragma unroll 8
    for (int i = 0; i < 32; ++i) { const int kk = 2 * i + (lane >> 5); scr[kk * 33 + (lane & 31)] = W[(size_t)(k0 + kk) * N + n0 + (lane & 31)]; }
    int r0 = n0;
    if (permute) { const int a = n0 & 255; r0 = (n0 & ~255) + 128 * ((a >> 5) & 1) + 32 * (a >> 6); }
    const int c = lane & 7;
#pragma unroll
    for (int j = 0; j < 4; ++j) { const int n = (lane >> 3) + 8 * j; const LAS float* s = scr + (8 * c) * 33 + n;
        u32x4 o; o.x = cvtpk(s[0 * 33], s[1 * 33]); o.y = cvtpk(s[2 * 33], s[3 * 33]); o.z = cvtpk(s[4 * 33], s[5 * 33]); o.w = cvtpk(s[6 * 33], s[7 * 33]);
        *(u32x4*)(WT + (size_t)(r0 + n) * K + k0 + 8 * c) = o; }
}

__global__ void __launch_bounds__(NTHREADS, 2) mega_fwd(Args a_kern) {
    extern __shared__ __attribute__((aligned(16))) unsigned char lds_raw[];
    cg::grid_group grid = cg::this_grid();
    const LASB lds = (LASB)lds_raw;
    const int G = gridDim.x, bid = blockIdx.x, NGW = G * NWAVES;
    const int vb = (G % 8 == 0) ? (bid % 8) * (G / 8) + bid / 8 : bid;
    if (threadIdx.x < 2) ((LAS unsigned*)(lds + WSCR_OFF))[threadIdx.x] = 0u;
    __syncthreads();
    (void)xcd_barrier_post((unsigned*)a_kern.ws + 4096, (volatile LAS unsigned*)(lds + WSCR_OFF));
#define GRID_BAR() do { XcdBarrier xb_; unsigned* bw_ = (unsigned*)a_kern.ws + 4096; asm volatile("" : "+s"(bw_)); xb_.bar = bw_; xb_.x = xb_xcc_id(); xb_.st = (volatile LAS unsigned*)(lds + WSCR_OFF); xcd_barrier(xb_); } while (0)
#define PHASE_ARGS() const __attribute__((address_space(4))) Args* ap = (const __attribute__((address_space(4))) Args*)__builtin_amdgcn_kernarg_segment_ptr(); asm volatile("" : "+s"(ap)); \
    bf16_t* WinT = (bf16_t*)(ap->ws + ap->off_wint); bf16_t* WpT = (bf16_t*)(ap->ws + ap->off_wpt); bf16_t* WoT = (bf16_t*)(ap->ws + ap->off_wot); \
    bf16_t* H = (bf16_t*)(ap->ws + ap->off_h); bf16_t* P = (bf16_t*)(ap->ws + ap->off_p); bf16_t* OG = (bf16_t*)(ap->ws + ap->off_og); bf16_t* MB = H; bf16_t* KV = (bf16_t*)(ap->ws + ap->off_kv); \
    (void)KV; (void)WinT; (void)WpT; (void)WoT; (void)H; (void)P; (void)OG; (void)MB
#define PHASE_IDS() PHASE_ARGS(); int tid = threadIdx.x; asm volatile("" : "+v"(tid)); const int lane = tid & 63, wave = __builtin_amdgcn_readfirstlane(tid >> 6), gw = bid * NWAVES + wave, r = lane & 31, h = lane >> 5; \
    (void)gw; (void)r; (void)h
    const int MC = a_kern.MC, NCH = NTOK / MC;

    {
        PHASE_IDS();
        LAS float* scr = (LAS float*)(lds + wave * 16384);
        constexpr int I_IN = 16 * (LDP / 32), I_PJ = 8 * 32, I_OUT = 16 * 32, PER_L = I_IN + 3 * I_PJ + I_OUT;
        for (int it = gw; it < 2 * PER_L; it += NGW) {
            const int l = it / PER_L; int q = it - l * PER_L;
            if (q < I_IN) { transpose_item(ap->w_in + (size_t)l * DM * LDP, DM, LDP, WinT + (size_t)l * LDP * DM, true, scr, q, lane); continue; } q -= I_IN;
            if (q < 3 * I_PJ) { const int b = q / I_PJ; q -= b * I_PJ; const float* W = (b == 0 ? ap->w_proj_a : (b == 1 ? ap->w_proj_b : ap->w_proj_c)) + (size_t)l * 512 * DM;
                transpose_item(W, 512, DM, WpT + ((size_t)l * 3 + b) * DM * 512, false, scr, q, lane); continue; } q -= 3 * I_PJ;
            transpose_item(ap->w_out + (size_t)l * DM * DM, DM, DM, WoT + (size_t)l * DM * DM, false, scr, q, lane);
        }
        __syncthreads();
    }

    for (int ch = 0; ch < NCH; ++ch) {
        const int tok0 = ch * MC; const bool is_prompt = tok0 < NTOK_PROMPT;
        const int T = is_prompt ? T_PROMPT : T_SAMPLE;
        for (int l = 0; l < 2; ++l) {
            {
                PHASE_IDS();
                float* xout = ap->out + (size_t)tok0 * DM;
                const float* xin = (l == 0) ? (is_prompt ? ap->x_prompt + (size_t)tok0 * DM : ap->x_sample + (size_t)(tok0 - NTOK_PROMPT) * DM) : xout;
                const float* g = ap->norm_g + l * DM;
                f32x4 gv[4];
#pragma unroll
                for (int j = 0; j < 4; ++j) gv[j] = ((const f32x4*)g)[lane + 64 * j];
                for (int row = gw; row < MC; row += 2 * NGW) {
                    const int row2 = row + NGW; const bool has2 = row2 < MC;
                    const f32x4* xr = (const f32x4*)(xin + (size_t)row * DM) + lane;
                    const f32x4* xr2 = (const f32x4*)(xin + (size_t)(has2 ? row2 : row) * DM) + lane;
                    f32x4 v[4], v2[4]; float s = 0.f, s2 = 0.f;
#pragma unroll
                    for (int j = 0; j < 4; ++j) { v[j] = xr[64 * j]; v2[j] = xr2[64 * j]; }
#pragma unroll
                    for (int j = 0; j < 4; ++j) { s += (v[j].x * v[j].x + v[j].y * v[j].y) + (v[j].z * v[j].z + v[j].w * v[j].w); s2 += (v2[j].x * v2[j].x + v2[j].y * v2[j].y) + (v2[j].z * v2[j].z + v2[j].w * v2[j].w); }
                    const float rstd = 1.0f / sqrtf(wave_sum(s) * (1.f / DM) + EPS), rstd2 = 1.0f / sqrtf(wave_sum(s2) * (1.f / DM) + EPS);
                    u32x2* o8 = (u32x2*)(H + (size_t)row * DM) + lane;
#pragma unroll
                    for (int j = 0; j < 4; ++j) { u32x2 w; w.x = cvtpk(v[j].x * rstd * gv[j].x, v[j].y * rstd * gv[j].y); w.y = cvtpk(v[j].z * rstd * gv[j].z, v[j].w * rstd * gv[j].w); o8[64 * j] = w; }
                    if (has2) {
                        u32x2* o82 = (u32x2*)(H + (size_t)row2 * DM) + lane;
#pragma unroll
                        for (int j = 0; j < 4; ++j) { u32x2 w; w.x = cvtpk(v2[j].x * rstd2 * gv[j].x, v2[j].y * rstd2 * gv[j].y); w.y = cvtpk(v2[j].z * rstd2 * gv[j].z, v2[j].w * rstd2 * gv[j].w); o82[64 * j] = w; }
                    }
                }
            }
            if (ch == 0 && l == 0) grid.sync(); else GRID_BAR();
            {
                PHASE_ARGS();
                pg8::Gemm g{H, WinT + (size_t)l * LDP * DM, MC, LDP, DM, 0, 0};
                pg8::StaticOrder<LDP, 1> S; S.init(MC, G, bid);
                pg8::EpiInProj E{P, ap->qk_gain_a + l * 128, ap->qk_gain_b + l * 128, ap->qk_gain_c + l * 128, KV, MC};
                pg8::gemm_phase<pg8::EpiInProj, pg8::StaticOrder<LDP, 1>, 1024, 1>(lds, g, S, E);
            }
            GRID_BAR();
            {
                PHASE_IDS();
                const float lam_init = (l == 0) ? 0.2f : 0.35550906759f;
                float lam;
                { const float* lv = ap->lambda_a + l * 256; const float d01 = wave_sum(lv[lane] * lv[64 + lane]), d23 = wave_sum(lv[128 + lane] * lv[192 + lane]); lam = expf(d01) - expf(d23) + lam_init; }
                const float oneml = 1.f - lam_init;
                bf16_t* OGA = OG; bf16_t* OGB = OG + (size_t)MC * 512; bf16_t* OGC = OG + (size_t)2 * MC * 512;
                {
                    float smax2;
                    { const float* ga = ap->qk_gain_a + l * 128; float gq = fabsf(ga[lane]), gk = fabsf(ga[64 + lane]);
#pragma unroll
                      for (int o_ = 1; o_ < 64; o_ <<= 1) { gq = fmaxf(gq, __shfl_xor(gq, o_)); gk = fmaxf(gk, __shfl_xor(gk, o_)); }
                      smax2 = 8.f * gq * gk * LOG2E; }
                    const int qbs = T / 128, npair = MC / 128, nA = npair * 4;
                    const int sub = wave >> 2;
                    unsigned* qctr = (unsigned*)ap->ws + 8192 + 64 * (ch * 2 + l);
                    volatile LAS int* ubox = (volatile LAS int*)(lds + WSCR_OFF + 16);
                    for (;;) {
                        if (tid == 0) ubox[0] = (int)__hip_atomic_fetch_add(qctr, 1u, __ATOMIC_RELAXED, __HIP_MEMORY_SCOPE_AGENT);
                        __syncthreads();
                        const int u = __builtin_amdgcn_readfirstlane(ubox[0]);
                        __syncthreads();
                        if (u >= nA) break;
                        const int pair = u % npair, head = 3 - u / npair, qb = pair % qbs, seq = pair / qbs;
                        const int seqtok = seq * T, q0 = qb * 128, qw = q0 + 32 * (wave & 3);
                        const float sl2 = exp2f(-2.f * (float)(head + 1)) * LOG2E;
                        const int Dh = (int)fminf(ceilf((2.f * smax2 + 150.f) / sl2) + 1.f, 16777216.f);
                        const int t_lo = max(0, (q0 - Dh) / 64), t_hi = min(T / 64 - 1, (q0 + 127 + Dh) / 64), nt = t_hi - t_lo + 1;
                        const bf16_t* qp = P + (size_t)(seqtok + qw + r) * LDP + QA + head * 128 + sub * 64 + 8 * h;
                        bf16x8 qf[4];
#pragma unroll
                        for (int sd = 0; sd < 4; ++sd) qf[sd] = *(const bf16x8*)(qp + 16 * sd);
                        f32x16 o[4] = {}; float m = -INFINITY, lsum = 0.f;
                        const bf16_t* kva = KV + ((size_t)head * MC + seqtok + 64 * t_lo) * 256;
                        {
                            BiasA bf; bf.fixm = (smax2 <= 40.f); bf.sl2 = sl2; bf.q = qw + r - 4 * h - 64 * t_lo; bf.dqh = 0.f; bf.M = bf.fixm ? smax2 : 0.f; bf.init_mfma(qw - 64 * t_lo, r, h);
                            flash<128, 128, 128, 64, 256, BiasA>(lds, kva, kva + 128, nt, qf, sub * 64, 0, bf, o, m, lsum, tid, lane);
                        }
                        const float inv = 1.0f / (lsum + __shfl_xor(lsum, 32));
#pragma unroll
                        for (int db = 0; db < 4; ++db)
#pragma unroll
                            for (int i = 0; i < 16; ++i) o[db][i] *= inv;
                        LAS float* cb = (LAS float*)lds + ((wave & 3) * 32 + r) * 132 + 4 * h;
                        if (sub == 1) {
#pragma unroll
                            for (int db = 0; db < 4; ++db)
#pragma unroll
                                for (int g = 0; g < 4; ++g) *(LAS f32x4*)(cb + 32 * db + 8 * g) = (f32x4){o[db][4 * g], o[db][4 * g + 1], o[db][4 * g + 2], o[db][4 * g + 3]};
                        }
                        __syncthreads();
                        if (sub == 0) {
                            float ss = 0.f;
#pragma unroll
                            for (int db = 0; db < 4; ++db)
#pragma unroll
                                for (int g = 0; g < 4; ++g) { const f32x4 c4 = *(LAS f32x4*)(cb + 32 * db + 8 * g);
#pragma unroll
                                    for (int e = 0; e < 4; ++e) { const float v = o[db][4 * g + e] - lam * c4[e]; o[db][4 * g + e] = v; ss += v * v; } }
                            ss += __shfl_xor(ss, 32);
                            const float rstd = oneml / sqrtf(ss * (1.f / 128.f) + EPS);
                            const size_t tok = (size_t)(seqtok + qw + r);
                            const float* sg = ap->subln_g_a + l * 128 + 4 * h;
                            const bf16_t* zp = P + tok * LDP + ZA + head * 128 + 4 * h;
                            bf16_t* op = OGA + tok * 512 + head * 128 + 4 * h;
#pragma unroll
                            for (int db = 0; db < 4; ++db)
#pragma unroll
                                for (int g = 0; g < 4; ++g) {
                                    const f32x4 s4 = *(const f32x4*)(sg + 32 * db + 8 * g); const u32x2 z2 = *(const u32x2*)(zp + 32 * db + 8 * g);
                                    const float y0 = o[db][4 * g] * rstd * s4[0] * __uint_as_float(z2.x << 16), y1 = o[db][4 * g + 1] * rstd * s4[1] * __uint_as_float(z2.x & 0xffff0000u);
                                    const float y2 = o[db][4 * g + 2] * rstd * s4[2] * __uint_as_float(z2.y << 16), y3 = o[db][4 * g + 3] * rstd * s4[3] * __uint_as_float(z2.y & 0xffff0000u);
                                    u32x2 w; w.x = cvtpk(y0, y1); w.y = cvtpk(y2, y3); *(u32x2*)(op + 32 * db + 8 * g) = w;
                                }
                        }
                        __syncthreads();
                    }
                }
                {
                    const int rows = T / 64, nB = (MC / 64) * 2;
                    LAS float* tab = (LAS float*)(lds + TAB_OFF);
                    const int perB = (nB + G - 1) / G;
                    for (int u = vb * perB; u < min(nB, (vb + 1) * perB); ++u) {
                        const int hg4 = u & 1, grow = u >> 1, seq = grow / rows, gr = grow % rows, seqtok = seq * T;
                        const int rs = min(max(gr - 4, 0), rows - 8);
                        const int head = hg4 * 4 + (wave >> 1), qc = 32 * (wave & 1) + r;
                        { const float* src = ap->rpb_b + ((size_t)l * 8 + hg4 * 4) * 465; for (int i = tid; i < 4 * 465; i += NTHREADS) tab[i] = src[i] * LOG2E; }
                        const size_t qtok = (size_t)(seqtok + gr * 64 + qc);
                        const bf16_t* qp = P + qtok * LDP + QB + head * 64 + 8 * h;
                        bf16x8 qf[4];
#pragma unroll
                        for (int sd = 0; sd < 4; ++sd) qf[sd] = *(const bf16x8*)(qp + 16 * sd);
                        BiasB bf; bf.hsel = wave & 1; bf.tabh = tab + (wave >> 1) * 465; bf.trow = bf.tabh; bf.qc = qc; bf.cs = min(max(qc - 8, 0), 48); bf.kc0 = 0; bf.rs_minus_gr = rs - gr; bf.h4 = 4 * h;
                        f32x16 o[2] = {}; float m = -INFINITY, lsum = 0.f;
                        const bf16_t* kvb = KV + (size_t)4 * MC * 256 + ((size_t)hg4 * MC + seqtok + rs * 64) * 512;
                        flash<64, 256, 256, 64, 512, BiasB>(lds, kvb, kvb + 256, 8, qf, (wave >> 1) * 64, (wave >> 1) * 64, bf, o, m, lsum, tid, lane);
                        const float inv = 1.0f / (lsum + __shfl_xor(lsum, 32));
                        const size_t tok = qtok;
                        const bf16_t* zp = P + tok * LDP + ZB + head * 64 + 4 * h;
                        bf16_t* op = OGB + tok * 512 + head * 64 + 4 * h;
#pragma unroll
                        for (int db = 0; db < 2; ++db)
#pragma unroll
                            for (int g = 0; g < 4; ++g) {
                                const u32x2 z2 = *(const u32x2*)(zp + 32 * db + 8 * g);
                                const float y0 = o[db][4 * g] * inv * __uint_as_float(z2.x << 16), y1 = o[db][4 * g + 1] * inv * __uint_as_float(z2.x & 0xffff0000u);
                                const float y2 = o[db][4 * g + 2] * inv * __uint_as_float(z2.y << 16), y3 = o[db][4 * g + 3] * inv * __uint_as_float(z2.y & 0xffff0000u);
                                u32x2 w; w.x = cvtpk(y0, y1); w.y = cvtpk(y2, y3); *(u32x2*)(op + 32 * db + 8 * g) = w;
                            }
                    }
                }
                {
                    const int qbs = T / 64, nC = (MC / 64) * 2;
                    const int perC = (nC + G - 1) / G;
                    for (int u = vb * perC; u < min(nC, (vb + 1) * perC); ++u) {
                        const int kv = u & 1, qq = u >> 1, seq = qq / qbs, qb = qq % qbs, seqtok = seq * T;
                        const int head = kv * 4 + (wave >> 1), qpos = qb * 64 + 32 * (wave & 1) + r;
                        const int t_lo = max(0, 2 - qb), t_hi = min(4, qbs + 1 - qb), nt = t_hi - t_lo + 1, key0 = qb * 64 - 128 + 64 * t_lo;
                        const bf16_t* qp = P + (size_t)(seqtok + qpos) * LDP + QC + head * 64 + 8 * h;
                        bf16x8 qf[4];
#pragma unroll
                        for (int sd = 0; sd < 4; ++sd) qf[sd] = *(const bf16x8*)(qp + 16 * sd);
                        BiasC bf; bf.sl2 = exp2f(-(float)(head + 1)) * LOG2E; bf.q = qpos - key0 - 4 * h; bf.dqh = 0.f;
                        f32x16 o[2] = {}; float m = -INFINITY, lsum = 0.f;
                        const bf16_t* kvc = KV + (size_t)4 * MC * 256 + (size_t)2 * MC * 512 + ((size_t)kv * MC + seqtok + key0) * 128;
                        flash<64, 64, 64, 64, 128, BiasC>(lds, kvc, kvc + 64, nt, qf, 0, 0, bf, o, m, lsum, tid, lane);
                        const float inv = 1.0f / (lsum + __shfl_xor(lsum, 32) + __builtin_amdgcn_exp2f(ap->sink_c[l * 8 + head] * LOG2E - m));
                        const size_t tok = (size_t)(seqtok + qpos);
                        const bf16_t* zp = P + tok * LDP + ZC + head * 64 + 4 * h;
                        bf16_t* op = OGC + tok * 512 + head * 64 + 4 * h;
#pragma unroll
                        for (int db = 0; db < 2; ++db)
#pragma unroll
                            for (int g = 0; g < 4; ++g) {
                                const u32x2 z2 = *(const u32x2*)(zp + 32 * db + 8 * g);
                                const float y0 = o[db][4 * g] * inv * __uint_as_float(z2.x << 16), y1 = o[db][4 * g + 1] * inv * __uint_as_float(z2.x & 0xffff0000u);
                                const float y2 = o[db][4 * g + 2] * inv * __uint_as_float(z2.y << 16), y3 = o[db][4 * g + 3] * inv * __uint_as_float(z2.y & 0xffff0000u);
                                u32x2 w; w.x = cvtpk(y0, y1); w.y = cvtpk(y2, y3); *(u32x2*)(op + 32 * db + 8 * g) = w;
                            }
                    }
                }
            }
            GRID_BAR();
            {
                PHASE_ARGS();
                pg8::Gemm g{OG, WpT + (size_t)l * 3 * DM * 512, MC, DM, 512, (size_t)MC * 512, (size_t)DM * 512};
                pg8::StaticOrder<DM, 3> S; S.init(MC, G, bid);
                pg8::EpiProjGate E{P, MB};
                pg8::gemm_phase<pg8::EpiProjGate, pg8::StaticOrder<DM, 3>, 512, 3>(lds, g, S, E);
            }
            GRID_BAR();
            {
                PHASE_ARGS();
                float* xout = ap->out + (size_t)tok0 * DM;
                const float* xin = (l == 0) ? (is_prompt ? ap->x_prompt + (size_t)tok0 * DM : ap->x_sample + (size_t)(tok0 - NTOK_PROMPT) * DM) : xout;
                pg8::Gemm g{MB, WoT + (size_t)l * DM * DM, MC, DM, DM, 0, 0};
                pg8::StaticOrder<DM, 1> S; S.init(MC, G, bid);
                pg8::EpiResid E{xin, xout};
                pg8::gemm_phase<pg8::EpiResid, pg8::StaticOrder<DM, 1>, 1024, 1>(lds, g, S, E);
            }
            if (!(ch == NCH - 1 && l == 1)) GRID_BAR();
        }
    }
}

extern "C" void kernel_launch(void* const* d_in, const int* in_sizes, int n_in, void* d_out, int out_size, void* d_ws, size_t ws_size, hipStream_t stream) {
    static int grid_blocks = 0;
    if (grid_blocks == 0) {
        int dev = 0, cus = 0, per_cu = 0;
        hipGetDevice(&dev);
        hipDeviceGetAttribute(&cus, hipDeviceAttributeMultiprocessorCount, dev);
        if (hipFuncSetAttribute((const void*)mega_fwd, hipFuncAttributeMaxDynamicSharedMemorySize, LDS_BYTES) != hipSuccess) fprintf(stderr, "hipFuncSetAttribute failed\n");
        if (hipOccupancyMaxActiveBlocksPerMultiprocessor(&per_cu, (const void*)mega_fwd, NTHREADS, LDS_BYTES) != hipSuccess || per_cu < 1) { fprintf(stderr, "occupancy query: %d\n", per_cu); per_cu = 1; }
        (void)hipGetLastError();
        grid_blocks = cus * 1;
        if (grid_blocks <= 0) grid_blocks = 256;
    }
    Args a{};
    a.x_prompt = (const float*)d_in[0]; a.x_sample = (const float*)d_in[1]; a.norm_g = (const float*)d_in[2]; a.w_in = (const float*)d_in[3];
    a.qk_gain_a = (const float*)d_in[4]; a.lambda_a = (const float*)d_in[5]; a.subln_g_a = (const float*)d_in[6]; a.qk_gain_b = (const float*)d_in[7];
    a.rpb_b = (const float*)d_in[8]; a.qk_gain_c = (const float*)d_in[9]; a.sink_c = (const float*)d_in[10]; a.w_proj_a = (const float*)d_in[11];
    a.w_proj_b = (const float*)d_in[12]; a.w_proj_c = (const float*)d_in[13]; a.w_out = (const float*)d_in[14];
    a.out = (float*)d_out; a.ws = (unsigned char*)d_ws;
    const unsigned long long MiB = 1ull << 20;
    a.off_wint = 1 * MiB; a.off_wpt = 35 * MiB; a.off_wot = 42 * MiB; a.off_h = 47 * MiB;
    int MC = 32768;
    auto need = [&](int mc) { return 47 * MiB + (unsigned long long)mc * DM * 2 + (unsigned long long)mc * LDP * 2 + (unsigned long long)mc * 1536 * 2 + (unsigned long long)mc * 2304 * 2; };
    if (need(MC) > ws_size) MC = 16384;
    if (need(MC) > ws_size) { fprintf(stderr, "kernel_launch: workspace too small (%zu)\n", ws_size); return; }
    a.MC = MC; a.pad = 0;
    a.off_p = a.off_h + (unsigned long long)MC * DM * 2;
    a.off_og = a.off_p + (unsigned long long)MC * LDP * 2;
    a.off_kv = a.off_og + (unsigned long long)MC * 1536 * 2;
    if (hipMemsetAsync(d_ws, 0, 65536, stream) != hipSuccess) fprintf(stderr, "kernel_launch: memset failed\n");
    void* args[] = {&a};
    hipError_t e = hipLaunchCooperativeKernel((const void*)mega_fwd, dim3(grid_blocks), dim3(NTHREADS), args, LDS_BYTES, stream);
    if (e != hipSuccess) fprintf(stderr, "cooperative launch failed: %s (grid %d)\n", hipGetErrorString(e), grid_blocks);
}
```

```cpp
#include <hip/hip_runtime.h>
#include <hip/hip_cooperative_groups.h>
#include <cstdio>
#include <cstdint>
namespace cg = cooperative_groups;

#define LAS __attribute__((address_space(3)))
typedef LAS unsigned char* LASB;
typedef unsigned short bf16_t;
typedef short bf16x8 __attribute__((ext_vector_type(8)));
typedef short s16x4 __attribute__((ext_vector_type(4)));
typedef float f32x4 __attribute__((ext_vector_type(4)));
typedef float f32x2 __attribute__((ext_vector_type(2)));
typedef float f32x16 __attribute__((ext_vector_type(16)));
typedef unsigned u32x4 __attribute__((ext_vector_type(4)));
typedef unsigned u32x2 __attribute__((ext_vector_type(2)));
typedef __bf16 bf16x2_t __attribute__((ext_vector_type(2)));

constexpr int DM = 1024, LDP = 8448, NTOK_PROMPT = 65536, NTOK = 98304, T_PROMPT = 4096, T_SAMPLE = 16384;
constexpr int QA = 0, KA = 512, VA = 1024, ZA = 1536, QB = 2048, KB = 2560, VB = 3072, ZB = 3584, QC = 4096, KC = 4608, VC = 4736, ZC = 4864, GA = 5376;
constexpr float EPS = 1e-6f, LOG2E = 1.4426950408889634f, QS = 0.125f * 1.4426950408889634f;
constexpr int NTHREADS = 512, NWAVES = 8;
constexpr int LDS_BYTES = 157696, WSCR_OFF = 147456, TAB_OFF = 148480;

__device__ __forceinline__ unsigned cvtpk(float lo, float hi) { f32x2 v = {lo, hi}; bf16x2_t b = __builtin_convertvector(v, bf16x2_t); return __builtin_bit_cast(unsigned, b); }
__device__ __forceinline__ float bf2f(unsigned short u) { return __uint_as_float(((unsigned)u) << 16); }
__device__ __forceinline__ float wave_sum(float v) {
#pragma unroll
    for (int o = 1; o < 64; o <<= 1) v += __shfl_xor(v, o);
    return v;
}

namespace pg8 {
constexpr int BM = 256, BK = 64, HALF = 128, HTB = HALF * BK * 2, STAGE_BYTES = 8 * HTB, NXCD = 8, WGM = 8;
__host__ __device__ __forceinline__ int lds_byte(int r, int c) { const int st = (r >> 4) * 2 + (c >> 5), rr = r & 15, cc = c & 31, ob = rr * 64 + cc * 2; return st * 1024 + (ob ^ (((ob >> 9) & 1) << 5)); }
__host__ __device__ __forceinline__ void stage_rc(int b, int& R, int& C) { const int st = b / 1024, sb = b % 1024, swz = sb ^ (((sb >> 9) & 1) << 5); R = (st >> 1) * 16 + swz / 64; C = (st & 1) * 32 + (swz % 64) / 2; }
__host__ __device__ __forceinline__ int perm32(int rho) { const int n = rho >> 4, i = rho & 15; return 8 * (i >> 2) + 4 * n + (i & 3); }

struct Unit { int pm, pn, kind; };
struct Gemm { const bf16_t* A; const bf16_t* Bt; int M, N, K; size_t sA, sB; };

template <int N, int NK> struct StaticOrder {
    int nwg8, G, c;
    __device__ __forceinline__ void init(int M, int G_, int c_) { nwg8 = (M / BM) * (N / BM) / NXCD; G = G_; c = c_; }
    __device__ __forceinline__ bool next(int i, Unit& u) const {
        constexpr int nN = N / BM, nig = WGM * nN;
        const int ti = i / NK; u.kind = i - ti * NK;
        const int L = ti * G + c; if (L >= nwg8 * NXCD) return false;
        const int wgid = (L & (NXCD - 1)) * nwg8 + (L >> 3);
        const int gid = wgid / nig, rem = wgid - gid * nig;
        u.pm = gid * WGM + (rem & (WGM - 1)); u.pn = rem / WGM; return true;
    }
};

struct EpiInProj {
    static constexpr bool PERM = true, CHAIN = false;
    bf16_t* P; const float* ga; const float* gb; const float* gc;
    bf16_t* KV; int MC;
    __device__ __forceinline__ void operator()(const f32x4 (&acc)[2][2][4][2], const Unit& u, int wr, int wc, int fr, int fq) const {
        const int hg = u.pn * 4 + wc;
        int mode; const float* gp = ga; float qs = 1.f;
        if (hg < 8) { mode = 1; gp = ga; qs = QS; }
        else if (hg < 16) { mode = 1; gp = ga + 64; }
        else if (hg < 24) mode = 0;
        else if (hg < 32) mode = 2;
        else if (hg < 40) { mode = 1; gp = gb; qs = QS; }
        else if (hg < 48) { mode = 1; gp = gb + 64; }
        else if (hg < 56) mode = 0;
        else if (hg < 64) mode = 2;
        else if (hg < 72) { mode = 1; gp = gc; qs = QS; }
        else if (hg < 74) { mode = 1; gp = gc + 64; }
        else if (hg < 76) mode = 0;
        else if (hg < 84) mode = 2;
        else mode = 3;
        float gv[2][8];
#pragma unroll
        for (int bj = 0; bj < 2; ++bj)
#pragma unroll
            for (int j = 0; j < 8; ++j) gv[bj][j] = (mode == 1) ? gp[32 * bj + 8 * fq + j] * qs : 1.f;
        const int col0 = hg * 64 + 8 * fq;
        size_t kvo = 0; int kvs = 0;
        if (hg >= 8 && hg < 16) { kvs = 256; kvo = (size_t)((hg - 8) >> 1) * MC * 256 + ((hg - 8) & 1) * 64; }
        else if (hg >= 16 && hg < 24) { kvs = 256; kvo = (size_t)((hg - 16) >> 1) * MC * 256 + 128 + ((hg - 16) & 1) * 64; }
        else if (hg >= 40 && hg < 48) { kvs = 512; kvo = (size_t)4 * MC * 256 + (size_t)((hg - 40) >> 2) * MC * 512 + ((hg - 40) & 3) * 64; }
        else if (hg >= 48 && hg < 56) { kvs = 512; kvo = (size_t)4 * MC * 256 + (size_t)((hg - 48) >> 2) * MC * 512 + 256 + ((hg - 48) & 3) * 64; }
        else if (hg >= 72 && hg < 74) { kvs = 128; kvo = (size_t)4 * MC * 256 + (size_t)2 * MC * 512 + (size_t)(hg - 72) * MC * 128; }
        else if (hg >= 74 && hg < 76) { kvs = 128; kvo = (size_t)4 * MC * 256 + (size_t)2 * MC * 512 + (size_t)(hg - 74) * MC * 128 + 64; }
#pragma unroll
        for (int ai = 0; ai < 2; ++ai)
#pragma unroll
            for (int m = 0; m < 4; ++m) {
                const int row = u.pm * BM + ai * HALF + wr * 64 + m * 16 + fr;
                float v[2][8];
#pragma unroll
                for (int bj = 0; bj < 2; ++bj)
#pragma unroll
                    for (int n = 0; n < 2; ++n)
#pragma unroll
                        for (int e = 0; e < 4; ++e) v[bj][4 * n + e] = acc[ai][bj][m][n][e];
                if (mode == 1) {
                    float ss = 0.f;
#pragma unroll
                    for (int bj = 0; bj < 2; ++bj)
#pragma unroll
                        for (int j = 0; j < 8; ++j) ss += v[bj][j] * v[bj][j];
                    ss += __shfl_xor(ss, 16); ss += __shfl_xor(ss, 32);
                    const float rstd = 1.0f / sqrtf(ss * (1.f / 64.f) + EPS);
#pragma unroll
                    for (int bj = 0; bj < 2; ++bj)
#pragma unroll
                        for (int j = 0; j < 8; ++j) v[bj][j] = v[bj][j] * rstd * gv[bj][j];
                } else if (mode == 2) {
#pragma unroll
                    for (int bj = 0; bj < 2; ++bj)
#pragma unroll
                        for (int j = 0; j < 8; ++j) v[bj][j] = v[bj][j] * __builtin_amdgcn_rcpf(1.f + __expf(-v[bj][j]));
                } else if (mode == 3) {
#pragma unroll
                    for (int bj = 0; bj < 2; ++bj)
#pragma unroll
                        for (int j = 0; j < 8; ++j) v[bj][j] = __builtin_amdgcn_rcpf(1.f + __expf(-v[bj][j]));
                }
                bf16_t* rowp = kvs ? KV + kvo + (size_t)row * kvs + 8 * fq : P + (size_t)row * LDP + col0;
#pragma unroll
                for (int bj = 0; bj < 2; ++bj) {
                    u32x4 w; w.x = cvtpk(v[bj][0], v[bj][1]); w.y = cvtpk(v[bj][2], v[bj][3]); w.z = cvtpk(v[bj][4], v[bj][5]); w.w = cvtpk(v[bj][6], v[bj][7]);
                    *(u32x4*)(rowp + 32 * bj) = w;
                }
            }
    }
};
struct EpiProjGate {
    static constexpr bool PERM = true, CHAIN = true;
    const bf16_t* P; bf16_t* MB;
    __device__ __forceinline__ void operator()(f32x4 (&acc)[2][2][4][2], const Unit& u, int wr, int wc, int fr, int fq) const {
        const int c0 = u.pn * BM + wc * 32 + 8 * fq;
        const int knext = u.kind < 2 ? u.kind + 1 : 2;
#pragma unroll
        for (int ai = 0; ai < 2; ++ai)
#pragma unroll
            for (int mp = 0; mp < 2; ++mp) {
                bf16x8 g[2][2], gn[2][2];
#pragma unroll
                for (int mm = 0; mm < 2; ++mm)
#pragma unroll
                    for (int bj = 0; bj < 2; ++bj) {
                        const int row = u.pm * BM + ai * HALF + wr * 64 + (2 * mp + mm) * 16 + fr, c = c0 + bj * HALF;
                        g[mm][bj] = *(const bf16x8*)(P + (size_t)row * LDP + GA + u.kind * 1024 + c);
                        gn[mm][bj] = *(const bf16x8*)(P + (size_t)row * LDP + GA + knext * 1024 + c);
                    }
                asm volatile("" ::: "memory");
                if (u.kind < 2) {
#pragma unroll
                    for (int mm = 0; mm < 2; ++mm)
#pragma unroll
                        for (int bj = 0; bj < 2; ++bj)
#pragma unroll
                            for (int n = 0; n < 2; ++n)
#pragma unroll
                                for (int e = 0; e < 4; ++e)
                                    acc[ai][bj][2 * mp + mm][n][e] *= bf2f((unsigned short)g[mm][bj][4 * n + e]) * __builtin_amdgcn_rcpf(fmaxf(bf2f((unsigned short)gn[mm][bj][4 * n + e]), 1e-30f));
                } else {
#pragma unroll
                    for (int mm = 0; mm < 2; ++mm)
#pragma unroll
                        for (int bj = 0; bj < 2; ++bj) {
                            const int row = u.pm * BM + ai * HALF + wr * 64 + (2 * mp + mm) * 16 + fr, c = c0 + bj * HALF;
                            float v[8];
#pragma unroll
                            for (int n = 0; n < 2; ++n)
#pragma unroll
                                for (int e = 0; e < 4; ++e) v[4 * n + e] = acc[ai][bj][2 * mp + mm][n][e] * bf2f((unsigned short)g[mm][bj][4 * n + e]);
                            u32x4 w; w.x = cvtpk(v[0], v[1]); w.y = cvtpk(v[2], v[3]); w.z = cvtpk(v[4], v[5]); w.w = cvtpk(v[6], v[7]);
                            *(u32x4*)(MB + (size_t)row * DM + c) = w;
                        }
                }
                asm volatile("" ::: "memory");
            }
    }
};
struct EpiResid {
    static constexpr bool PERM = false, CHAIN = false;
    const float* xin; float* out;
    __device__ __forceinline__ void operator()(const f32x4 (&acc)[2][2][4][2], const Unit& u, int wr, int wc, int fr, int fq) const {
        const int c0 = u.pn * BM + wc * 32 + 4 * fq;
#pragma unroll
        for (int ai = 0; ai < 2; ++ai) {
            f32x4 b[4][2][2];
#pragma unroll
            for (int m = 0; m < 4; ++m) { const size_t off = (size_t)(u.pm * BM + ai * HALF + wr * 64 + m * 16 + fr) * DM + c0;
#pragma unroll
                for (int bj = 0; bj < 2; ++bj)
#pragma unroll
                    for (int n = 0; n < 2; ++n) b[m][bj][n] = *(const f32x4*)(xin + off + bj * HALF + n * 16); }
            asm volatile("" ::: "memory");
#pragma unroll
            for (int m = 0; m < 4; ++m) { const size_t off = (size_t)(u.pm * BM + ai * HALF + wr * 64 + m * 16 + fr) * DM + c0;
#pragma unroll
                for (int bj = 0; bj < 2; ++bj)
#pragma unroll
                    for (int n = 0; n < 2; ++n) *(f32x4*)(out + off + bj * HALF + n * 16) = b[m][bj][n] + acc[ai][bj][m][n]; }
            asm volatile("" ::: "memory");
        }
    }
};

template <class Epi, class Sched, int K, int NK>
__device__ __forceinline__ void gemm_phase(LASB lds, const Gemm g, const Sched& S, const Epi& E) {
    int tid = threadIdx.x; asm volatile("" : "+v"(tid));
    const int wid = __builtin_amdgcn_readfirstlane(tid >> 6), lane = tid & 63, wr = wid >> 2, wc = wid & 3, fr = lane & 15, fq = lane >> 4;
    constexpr int nt = K / BK;
    unsigned voffA[2], voffB[2];
#pragma unroll
    for (int i = 0; i < 2; ++i) { int R, C; stage_rc(tid * 16 + i * 8192, R, C); const int Rb = Epi::PERM ? ((R & ~31) + perm32(R & 31)) : R;
        voffA[i] = (unsigned)(R * K + C) * 2u; voffB[i] = (unsigned)(Rb * K + C) * 2u; }
    constexpr size_t kstep = (size_t)(BK * 2);
    constexpr size_t hstep = (size_t)HALF * K * 2;
    constexpr size_t tstep = 2 * hstep;
    const unsigned ldsw = (unsigned)wid * 1024u;
    const int aoff = lds_byte(wr * 64 + fr, fq * 8), boff = lds_byte(wc * 32 + fr, fq * 8);
#define PG8_SA(b, h) (((b) * 2 + (h)) * HTB)
#define PG8_SB(b, h) ((4 + (b) * 2 + (h)) * HTB)
#define PG8_STAGE(bufoff, gbase, voff) do { _Pragma("unroll") for (int _i = 0; _i < 2; ++_i) \
        __builtin_amdgcn_global_load_lds((const unsigned*)((const char*)(gbase) + (voff)[_i]), (LAS unsigned*)(lds + (bufoff) + ldsw + _i * 8192), 16, 0, 0); } while (0)
#define PG8_LDA(dst, b, h) do { _Pragma("unroll") for (int m = 0; m < 4; ++m) _Pragma("unroll") for (int k = 0; k < 2; ++k) dst[m][k] = *(const LAS bf16x8*)(lds + PG8_SA(b, h) + aoff + m * 2048 + k * 1024); } while (0)
#define PG8_LDB(dst, b, h) do { _Pragma("unroll") for (int n = 0; n < 2; ++n) _Pragma("unroll") for (int k = 0; k < 2; ++k) dst[n][k] = *(const LAS bf16x8*)(lds + PG8_SB(b, h) + boff + n * 2048 + k * 1024); } while (0)
#define PG8_MMA(ai, bj, At, Bt) do { __builtin_amdgcn_s_setprio(1); _Pragma("unroll") for (int m = 0; m < 4; ++m) _Pragma("unroll") for (int n = 0; n < 2; ++n) _Pragma("unroll") for (int k = 0; k < 2; ++k) \
        acc[ai][bj][m][n] = __builtin_amdgcn_mfma_f32_16x16x32_bf16(Bt[n][k], At[m][k], acc[ai][bj][m][n], 0, 0, 0); __builtin_amdgcn_s_setprio(0); } while (0)
#define PG8_WAIT_V(n) asm volatile("s_waitcnt vmcnt(" #n ")" ::: "memory")
#define PG8_WAIT_L(n) asm volatile("s_waitcnt lgkmcnt(" #n ")" ::: "memory")
#define PG8_BAR __builtin_amdgcn_s_barrier()
#define PG8_SCHED __builtin_amdgcn_sched_barrier(0)
    Unit cur, nxt; int ui = 0;
    if (!S.next(0, cur)) return;
    f32x4 acc[2][2][4][2];
#pragma unroll
    for (int a = 0; a < 2; ++a)
#pragma unroll
        for (int b = 0; b < 2; ++b)
#pragma unroll
            for (int m = 0; m < 4; ++m)
#pragma unroll
                for (int n = 0; n < 2; ++n) acc[a][b][m][n] = (f32x4){0.f, 0.f, 0.f, 0.f};
    bf16x8 At[4][2], B0[2][2], B1[2][2];
    const char* cA = (const char*)(g.A + (NK > 1 ? (size_t)cur.kind * g.sA : 0)) + (size_t)cur.pm * tstep; const char* cB = (const char*)(g.Bt + (NK > 1 ? (size_t)cur.kind * g.sB : 0)) + (size_t)cur.pn * tstep;
    PG8_STAGE(PG8_SB(0, 0), cB, voffB); PG8_STAGE(PG8_SB(0, 1), cB + hstep, voffB); PG8_STAGE(PG8_SA(0, 0), cA, voffA); PG8_STAGE(PG8_SA(0, 1), cA + hstep, voffA);
    if (wr == 1) PG8_BAR;
    PG8_WAIT_V(2); PG8_BAR;
    PG8_STAGE(PG8_SB(1, 0), cB + kstep, voffB); PG8_STAGE(PG8_SA(1, 0), cA + kstep, voffA); PG8_STAGE(PG8_SB(1, 1), cB + hstep + kstep, voffB);
    PG8_WAIT_V(6); PG8_BAR;
    for (;;) {
        const bool has_next = S.next(ui + 1, nxt);
        const char* nA = has_next ? (const char*)(g.A + (NK > 1 ? (size_t)nxt.kind * g.sA : 0)) + (size_t)nxt.pm * tstep : cA;
        const char* nB = has_next ? (const char*)(g.Bt + (NK > 1 ? (size_t)nxt.kind * g.sB : 0)) + (size_t)nxt.pn * tstep : cB;
        for (int t = 0; t < nt; t += 2) {
            const bool last = (t == nt - 2);
            const char* a1 = cA + (size_t)(t + 1) * kstep;
            const char* a2 = last ? nA : cA + (size_t)(t + 2) * kstep; const char* b2 = last ? nB : cB + (size_t)(t + 2) * kstep;
            const char* a3 = a2 + kstep; const char* b3 = b2 + kstep;
            PG8_LDB(B0, 0, 0); PG8_LDB(B1, 0, 1); PG8_SCHED; PG8_LDA(At, 0, 0); PG8_STAGE(PG8_SA(1, 1), a1 + hstep, voffA);
            PG8_WAIT_V(8); PG8_WAIT_L(0); PG8_BAR; PG8_MMA(0, 0, At, B0); PG8_MMA(0, 1, At, B1); PG8_BAR; PG8_SCHED;
            PG8_LDA(At, 0, 1); PG8_STAGE(PG8_SB(0, 0), b2, voffB); PG8_STAGE(PG8_SB(0, 1), b2 + hstep, voffB); PG8_STAGE(PG8_SA(0, 0), a2, voffA);
            PG8_WAIT_V(8); PG8_WAIT_L(0); PG8_BAR; PG8_MMA(1, 0, At, B0); PG8_MMA(1, 1, At, B1); PG8_BAR; PG8_SCHED;
            PG8_LDB(B0, 1, 0); PG8_LDB(B1, 1, 1); PG8_SCHED; PG8_LDA(At, 1, 0); PG8_STAGE(PG8_SA(0, 1), a2 + hstep, voffA);
            PG8_WAIT_V(8); PG8_WAIT_L(0); PG8_BAR; PG8_MMA(0, 0, At, B0); PG8_MMA(0, 1, At, B1); PG8_BAR; PG8_SCHED;
            PG8_LDA(At, 1, 1); PG8_STAGE(PG8_SB(1, 0), b3, voffB); PG8_STAGE(PG8_SB(1, 1), b3 + hstep, voffB); PG8_STAGE(PG8_SA(1, 0), a3, voffA);
            PG8_WAIT_V(8); PG8_WAIT_L(0); PG8_BAR; PG8_MMA(1, 0, At, B0); PG8_MMA(1, 1, At, B1); PG8_BAR; PG8_SCHED;
        }
        if (wr == 0) PG8_BAR;
        E(acc, cur, wr, wc, fr, fq);
        if (!has_next) break;
        if (!(Epi::CHAIN && nxt.kind != 0))
#pragma unroll
        for (int a = 0; a < 2; ++a)
#pragma unroll
            for (int b = 0; b < 2; ++b)
#pragma unroll
                for (int m = 0; m < 4; ++m)
#pragma unroll
                    for (int n = 0; n < 2; ++n) acc[a][b][m][n] = (f32x4){0.f, 0.f, 0.f, 0.f};
        cur = nxt; cA = nA; cB = nB; ++ui;
        if (wr == 1) PG8_BAR;
    }
    PG8_WAIT_V(0);
    PG8_BAR;
#undef PG8_SA
#undef PG8_SB
#undef PG8_STAGE
#undef PG8_LDA
#undef PG8_LDB
#undef PG8_MMA
#undef PG8_WAIT_V
#undef PG8_WAIT_L
#undef PG8_BAR
#undef PG8_SCHED
}
}

#define MFMA32(a, b, c) __builtin_amdgcn_mfma_f32_32x32x16_bf16((a), (b), (c), 0, 0, 0)
#define SCHED_FENCE() __builtin_amdgcn_sched_barrier(0)
typedef short v4i16_t __attribute__((ext_vector_type(4)));
__device__ __forceinline__ s16x4 tr_read(LASB p) { return __builtin_bit_cast(s16x4, __builtin_amdgcn_ds_read_tr16_b64_v4i16((LAS v4i16_t*)p)); }
__device__ __forceinline__ int crow(int i, int h) { return (i & 3) + 8 * (i >> 2) + 4 * h; }
template <int DV, int KW, int VW, int KT, int RS, class BF>
__device__ __forceinline__ void flash(LASB lds, const bf16_t* kbase, const bf16_t* vbase, int nt, const bf16x8 (&qf)[4], int kcol, int vcol, BF& bf,
                                      f32x16 (&o)[DV / 32], float& m, float& l, int tid, int lane) {
    constexpr int KSTR = KW * 2 + 16, VSTR = VW * 2 + 64, KBY = KT * KSTR, BUF = KT * KSTR + KT * VSTR;
    constexpr int KPR = KW / 8, VPR = VW / 8, NPK = KT * KPR / NTHREADS, NPV = KT * VPR / NTHREADS, NKT = KT / 32, NDB = DV / 32;
    static_assert(NPK >= 1 && NPV >= 1 && 2 * BUF <= WSCR_OFF, "flash geometry");
    const int r = lane & 31, h = lane >> 5;
    u32x4 kr[NPK], vr[NPV];
    int kgo[NPK], klo[NPK], vgo[NPV], vlo[NPV];
#pragma unroll
    for (int i = 0; i < NPK; ++i) { const int pid = tid + NTHREADS * i, row = pid / KPR, cp = pid % KPR; kgo[i] = row * RS + cp * 8; klo[i] = row * KSTR + cp * 16; }
#pragma unroll
    for (int i = 0; i < NPV; ++i) { const int pid = tid + NTHREADS * i, row = pid / VPR, cp = pid % VPR; vgo[i] = row * RS + cp * 8; vlo[i] = KBY + row * VSTR + cp * 16; }
    const int koff = r * KSTR + (kcol + 8 * h) * 2;
    const int voff = KBY + (4 * h + ((lane & 15) >> 2)) * VSTR + (vcol + 16 * ((lane >> 4) & 1) + 4 * (lane & 3)) * 2;
#pragma unroll
    for (int i = 0; i < NPK; ++i) kr[i] = *(const u32x4*)(kbase + kgo[i]);
#pragma unroll
    for (int i = 0; i < NPV; ++i) vr[i] = *(const u32x4*)(vbase + vgo[i]);
#pragma unroll
    for (int i = 0; i < NPK; ++i) *(LAS u32x4*)(lds + klo[i]) = kr[i];
#pragma unroll
    for (int i = 0; i < NPV; ++i) *(LAS u32x4*)(lds + vlo[i]) = vr[i];
    __syncthreads();
    for (int t = 0; t < nt; ++t) {
        const LASB buf = lds + (t & 1) * BUF;
        if (t + 1 < nt) {
            const bf16_t* kb = kbase + (size_t)(t + 1) * KT * RS; const bf16_t* vb = vbase + (size_t)(t + 1) * KT * RS;
#pragma unroll
            for (int i = 0; i < NPK; ++i) kr[i] = *(const u32x4*)(kb + kgo[i]);
#pragma unroll
            for (int i = 0; i < NPV; ++i) vr[i] = *(const u32x4*)(vb + vgo[i]);
        }
        bf.set_tile(t);
        bf16x8 kf[NKT][2];
#pragma unroll
        for (int kt = 0; kt < NKT; ++kt)
#pragma unroll
            for (int sd = 0; sd < 2; ++sd) kf[kt][sd] = *(const LAS bf16x8*)(buf + koff + kt * 32 * KSTR + sd * 32);
        f32x16 S[NKT];
#pragma unroll
        for (int kt = 0; kt < NKT; ++kt) {
            if constexpr (BF::FIXM) S[kt] = MFMA32(bf.abias[kt], bf.bbias, (f32x16){});
            else S[kt] = (f32x16){};
        }
        SCHED_FENCE();
        bf16x8 kg[NKT][2];
#pragma unroll
        for (int kt = 0; kt < NKT; ++kt)
#pragma unroll
            for (int sd = 0; sd < 2; ++sd) kg[kt][sd] = *(const LAS bf16x8*)(buf + koff + kt * 32 * KSTR + (sd + 2) * 32);
#pragma unroll
        for (int sd = 0; sd < 2; ++sd)
#pragma unroll
            for (int kt = 0; kt < NKT; ++kt) S[kt] = MFMA32(kf[kt][sd], qf[sd], S[kt]);
        SCHED_FENCE();
        bf16x8 vf[2][NDB];
#pragma unroll
        for (int db = 0; db < NDB; ++db) { const LASB vp = buf + voff + db * 64; const s16x4 lo = tr_read(vp), hi = tr_read(vp + 8 * VSTR); vf[0][db] = __builtin_shufflevector(lo, hi, 0, 1, 2, 3, 4, 5, 6, 7); }
#pragma unroll
        for (int sd = 0; sd < 2; ++sd)
#pragma unroll
            for (int kt = 0; kt < NKT; ++kt) S[kt] = MFMA32(kg[kt][sd], qf[sd + 2], S[kt]);
        SCHED_FENCE();
        f32x2 rs2 = {0.f, 0.f}; float rsa = 0.f;
        if (BF::FIXM && bf.fixm) {
            if (bf.diag) {
#pragma unroll
                for (int kt = 0; kt < NKT; ++kt)
#pragma unroll
                    for (int i = 0; i < 16; ++i) S[kt][i] = bf.apply(S[kt][i], kt * 32 + (i & 3) + 8 * (i >> 2));
            }
#pragma unroll
            for (int kt = 0; kt < NKT; ++kt)
#pragma unroll
                for (int i = 0; i < 16; ++i) { const float p0 = __builtin_amdgcn_exp2f(S[kt][i]); S[kt][i] = p0; rsa += p0; asm volatile("" : "+v"(rsa)); }
            l += rsa;
        } else {
#define FLASH_LIVE(HS, kt, i) ((HS) < 0 || ((HS) == 0 ? ((kt) == 0 || ((i) >> 2) == 0) : ((kt) == NKT - 1 || ((i) >> 2) == 3)))
#define FLASH_SOFTMAX(HS) do { \
            float mx = -INFINITY; \
            _Pragma("unroll") for (int kt = 0; kt < NKT; ++kt) \
            _Pragma("unroll") for (int i = 0; i < 16; ++i) if (FLASH_LIVE(HS, kt, i)) { const float v = (!BF::FIXM || bf.diag) ? bf.apply(S[kt][i], kt * 32 + (i & 3) + 8 * (i >> 2)) : S[kt][i]; S[kt][i] = v; mx = fmaxf(mx, v); } \
            mx = fmaxf(mx, __shfl_xor(mx, 32)); \
            const float mnew = fmaxf(m, mx); muse = (mnew == -INFINITY) ? 0.f : mnew; \
            alpha = __builtin_amdgcn_exp2f(m - muse); \
            m = mnew; \
            _Pragma("unroll") for (int kt = 0; kt < NKT; ++kt) \
            _Pragma("unroll") for (int i = 0; i < 16; i += 2) { \
                if (FLASH_LIVE(HS, kt, i)) { const float p0 = __builtin_amdgcn_exp2f(S[kt][i] - muse), p1 = __builtin_amdgcn_exp2f(S[kt][i + 1] - muse); S[kt][i] = p0; S[kt][i + 1] = p1; rs2 += (f32x2){p0, p1}; } \
                else { S[kt][i] = 0.f; S[kt][i + 1] = 0.f; } } } while (0)
            float muse, alpha;
            if constexpr (BF::HALFMASK) { if (bf.hsel == 0) FLASH_SOFTMAX(0); else FLASH_SOFTMAX(1); }
            else FLASH_SOFTMAX(-1);
#undef FLASH_SOFTMAX
#undef FLASH_LIVE
            l = l * alpha + (rs2.x + rs2.y);
            if (__any(alpha != 1.f)) {
#pragma unroll
                for (int db = 0; db < NDB; ++db)
#pragma unroll
                    for (int i = 0; i < 16; ++i) o[db][i] *= alpha;
            }
        }
        bf16x8 pf[NKT][2];
#pragma unroll
        for (int kt = 0; kt < NKT; ++kt)
#pragma unroll
            for (int s = 0; s < 2; ++s) {
                u32x4 w; w.x = cvtpk(S[kt][8 * s + 0], S[kt][8 * s + 1]); w.y = cvtpk(S[kt][8 * s + 2], S[kt][8 * s + 3]);
                w.z = cvtpk(S[kt][8 * s + 4], S[kt][8 * s + 5]); w.w = cvtpk(S[kt][8 * s + 6], S[kt][8 * s + 7]);
                pf[kt][s] = __builtin_bit_cast(bf16x8, w);
            }
        SCHED_FENCE();
#pragma unroll
        for (int st = 0; st < 2 * NKT; ++st) {
            if (st + 1 < 2 * NKT) {
#pragma unroll
                for (int db = 0; db < NDB; ++db) { const LASB vp = buf + voff + (16 * (st + 1)) * VSTR + db * 64; const s16x4 lo = tr_read(vp), hi = tr_read(vp + 8 * VSTR); vf[(st + 1) & 1][db] = __builtin_shufflevector(lo, hi, 0, 1, 2, 3, 4, 5, 6, 7); }
            }
#pragma unroll
            for (int db = 0; db < NDB; ++db) o[db] = MFMA32(vf[st & 1][db], pf[st >> 1][st & 1], o[db]);
            SCHED_FENCE();
        }
        if (t + 1 < nt) {
            const LASB nb = lds + ((t + 1) & 1) * BUF;
#pragma unroll
            for (int i = 0; i < NPK; ++i) *(LAS u32x4*)(nb + klo[i]) = kr[i];
#pragma unroll
            for (int i = 0; i < NPV; ++i) *(LAS u32x4*)(nb + vlo[i]) = vr[i];
        }
        __syncthreads();
    }
}

__device__ __forceinline__ float bf_round(float x) { return __uint_as_float(cvtpk(x, 0.f) << 16); }
struct BiasA {
    static constexpr bool FIXM = true, HALFMASK = false;
    bool fixm; float sl2; int q; float dqh; float M;
    int qrel, rlane, hl; bool diag; float s_hi, s_mid, s_lo; bf16x8 abias[2], bbias;
    __device__ __forceinline__ void init_mfma(int qrel_, int r, int h) {
        qrel = qrel_; rlane = r; hl = h; diag = false;
        s_hi = bf_round(sl2); s_mid = bf_round(sl2 - s_hi); s_lo = bf_round(sl2 - s_hi - s_mid);
#pragma unroll
        for (int kt = 0; kt < 2; ++kt) { const float j = (float)(kt * 32 + r); u32x4 w;
            if (h == 0) { w.x = cvtpk(j, j); w.y = cvtpk(j, s_hi); w.z = cvtpk(s_mid, s_lo); w.w = cvtpk(1.f, 1.f); } else { w.x = cvtpk(1.f, 0.f); w.y = 0u; w.z = 0u; w.w = 0u; }
            abias[kt] = __builtin_bit_cast(bf16x8, w); }
        bbias = abias[0];
    }
    __device__ __forceinline__ void set_tile(int t) {
        dqh = (float)(q - 64 * t);
        {
            const int dd = qrel - 64 * t;
            diag = (dd == 0) || (dd == 32);
            const float sg = diag ? 0.f : (dd > 0 ? 1.f : -1.f);
            const float c = diag ? -M : -sl2 * fabsf((float)dd) - M;
            const float c_hi = bf_round(c), c_mid = bf_round(c - c_hi), c_lo = bf_round(c - c_hi - c_mid);
            const float nr = -sg * (float)rlane;
            u32x4 w;
            if (hl == 0) { w.x = cvtpk(sg * s_hi, sg * s_mid); w.y = cvtpk(sg * s_lo, nr); w.z = cvtpk(nr, nr); w.w = cvtpk(c_hi, c_mid); } else { w.x = cvtpk(c_lo, 0.f); w.y = 0u; w.z = 0u; w.w = 0u; }
            bbias = __builtin_bit_cast(bf16x8, w);
        }
    }
    __device__ __forceinline__ float apply(float s, int c) const { const float d = dqh - (float)c; return __builtin_fmaf(-sl2, __builtin_fabsf(d), s); }
};
struct BiasC {
    static constexpr bool FIXM = false, fixm = false, diag = true, HALFMASK = false; static constexpr float M = 0.f;
    float sl2; int q; float dqh;
    __device__ __forceinline__ void set_tile(int t) { dqh = (float)(q - 64 * t); }
    __device__ __forceinline__ float apply(float s, int c) const { const float d = __builtin_fabsf(dqh - (float)c); return d <= 128.f ? __builtin_fmaf(-sl2, d, s) : -INFINITY; }
};
struct BiasB {
    static constexpr bool FIXM = false, fixm = false, diag = true, HALFMASK = true; static constexpr float M = 0.f;
    int hsel;
    const LAS float* tabh; const LAS float* trow; int qc, cs, kc0, rs_minus_gr, h4;
    __device__ __forceinline__ void set_tile(int t) { trow = tabh + (rs_minus_gr + t + 7) * 31; kc0 = h4; }
    __device__ __forceinline__ float apply(float s, int c) const {
        const int kc = kc0 + c; const bool valid = (unsigned)(kc - cs) < 16u; const int idx = valid ? (kc - qc + 15) : 0;
        return valid ? s + trow[idx] : -INFINITY;
    }
};


#define XB_TMO      128
#define XB_XCNT(j)  (256  + 64 * (j))
#define XB_XSUB(j)  (1280 + 64 * (j))
#define XB_XGEN(j)  (2304 + 64 * (j))
#define XB_TOP      3328
#define XB_TOPGEN   3392
#define XCD_BAR_WORDS 3456
#define XB_SPIN_CAP (1u << 22)
__device__ __forceinline__ unsigned xb_ld(unsigned* p)              { return __hip_atomic_load(p, __ATOMIC_RELAXED, __HIP_MEMORY_SCOPE_AGENT); }
__device__ __forceinline__ unsigned xb_add(unsigned* p, unsigned v) { return __hip_atomic_fetch_add(p, v, __ATOMIC_RELAXED, __HIP_MEMORY_SCOPE_AGENT); }
__device__ __forceinline__ unsigned xb_xcc_id() { return (unsigned)__builtin_amdgcn_s_getreg((3 << 11) | 20) & 0xFu; }
#define XB_SPIN(cond, bar) do { unsigned _sp = 0; while (cond) { __builtin_amdgcn_s_sleep(1); \
    if ((++_sp & 255u) == 0u) { if (xb_ld(&(bar)[XB_TMO])) break; if (_sp > XB_SPIN_CAP) { atomicAdd(&(bar)[XB_TMO], 1u); break; } } } } while (0)
struct XcdBarrier { unsigned* bar; unsigned x; volatile LAS unsigned* st; };
__device__ __forceinline__ XcdBarrier xcd_barrier_post(unsigned* bar, volatile LAS unsigned* st) {
    XcdBarrier b; b.bar = bar; b.x = xb_xcc_id(); b.st = st;
    if (threadIdx.x == 0) (void)xb_add(&bar[XB_XCNT(b.x)], 1u);
    return b;
}
__device__ __forceinline__ void xcd_barrier_complete(unsigned* bar, unsigned x, unsigned& nloc, unsigned& nx) {
    const unsigned G = gridDim.x * gridDim.y * gridDim.z;
    unsigned sum, cnt, mine, sp = 0u;
    for (;;) {
        sum = 0u; cnt = 0u; mine = 0u;
#pragma unroll 1
        for (unsigned j = 0; j < 16; ++j) { const unsigned c = xb_ld(&bar[XB_XCNT(j)]); sum += c; cnt += (c > 0u) ? 1u : 0u; mine = (j == x) ? c : mine; }
        if (sum == G) break;
        __builtin_amdgcn_s_sleep(1);
        if ((++sp & 255u) == 0u) { if (xb_ld(&bar[XB_TMO])) break; if (sp > XB_SPIN_CAP) { atomicAdd(&bar[XB_TMO], 1u); break; } }
    }
    nloc = mine > 0u ? mine : 1u; nx = cnt > 0u ? cnt : 1u;
}
__device__ __forceinline__ void xcd_barrier(const XcdBarrier& b) {
    asm volatile("s_waitcnt vmcnt(0)" ::: "memory");
    __syncthreads();
    if (threadIdx.x == 0) {
        unsigned* bar = b.bar;
        __builtin_amdgcn_s_waitcnt(0);
        unsigned nloc = b.st[0], nx = b.st[1];
        if (nloc == 0u) { xcd_barrier_complete(bar, b.x, nloc, nx); b.st[0] = nloc; b.st[1] = nx; }
        const unsigned old = xb_add(&bar[XB_XSUB(b.x)], 1u);
        const unsigned gen = old / nloc;
        if (old + 1u == (gen + 1u) * nloc) {
            __builtin_amdgcn_fence(__ATOMIC_RELEASE, "agent");
            asm volatile("s_waitcnt vmcnt(0)" ::: "memory");
            const unsigned og = xb_add(&bar[XB_TOP], 1u);
            const unsigned tg = og / nx;
            if (og + 1u == (tg + 1u) * nx) xb_add(&bar[XB_TOPGEN], 1u);
            else XB_SPIN(xb_ld(&bar[XB_TOPGEN]) == tg, bar);
            __builtin_amdgcn_fence(__ATOMIC_ACQUIRE, "agent");
            xb_add(&bar[XB_XGEN(b.x)], 1u);
            asm volatile("s_waitcnt vmcnt(0)" ::: "memory");
        } else {
            XB_SPIN(xb_ld(&bar[XB_XGEN(b.x)]) == gen, bar);
            __builtin_amdgcn_fence(__ATOMIC_ACQUIRE, "agent");
            asm volatile("s_waitcnt vmcnt(0)" ::: "memory");
        }
    }
    __syncthreads();
}

struct Args {
    const float* x_prompt; const float* x_sample; const float* norm_g; const float* w_in; const float* qk_gain_a; const float* lambda_a; const float* subln_g_a;
    const float* qk_gain_b; const float* rpb_b; const float* qk_gain_c; const float* sink_c; const float* w_proj_a; const float* w_proj_b; const float* w_proj_c; const float* w_out;
    float* out; unsigned char* ws;
    unsigned long long off_wint, off_wpt, off_wot, off_h, off_p, off_og, off_kv;
    int MC, pad;
};

__device__ __forceinline__ void transpose_item(const float* W, int K, int N, bf16_t* WT, bool permute, LAS float* scr, int item, int lane) {
    const int nblk = N / 32, kb = item / nblk, nb = item % nblk, k0 = 64 * kb, n0 = 32 * nb;
#pragma unroll 8
    for (int i = 0; i < 32; ++i) { const int kk = 2 * i + (lane >> 5); scr[kk * 33 + (lane & 31)] = W[(size_t)(k0 + kk) * N + n0 + (lane & 31)]; }
    int r0 = n0;
    if (permute) { const int a = n0 & 255; r0 = (n0 & ~255) + 128 * ((a >> 5) & 1) + 32 * (a >> 6); }
    const int c = lane & 7;
#pragma unroll
    for (int j = 0; j < 4; ++j) { const int n = (lane >> 3) + 8 * j; const LAS float* s = scr + (8 * c) * 33 + n;
        u32x4 o; o.x = cvtpk(s[0 * 33], s[1 * 33]); o.y = cvtpk(s[2 * 33], s[3 * 33]); o.z = cvtpk(s[4 * 33], s[5 * 33]); o.w = cvtpk(s[6 * 33], s[7 * 33]);
        *(u32x4*)(WT + (size_t)(r0 + n) * K + k0 + 8 * c) = o; }
}

__global__ void __launch_bounds__(NTHREADS, 2) mega_fwd(Args a_kern) {
    extern __shared__ __attribute__((aligned(16))) unsigned char lds_raw[];
    cg::grid_group grid = cg::this_grid();
    const LASB lds = (LASB)lds_raw;
    const int G = gridDim.x, bid = blockIdx.x, NGW = G * NWAVES;
    const int vb = (G % 8 == 0) ? (bid % 8) * (G / 8) + bid / 8 : bid;
    if (threadIdx.x < 2) ((LAS unsigned*)(lds + WSCR_OFF))[threadIdx.x] = 0u;
    __syncthreads();
    (void)xcd_barrier_post((unsigned*)a_kern.ws + 4096, (volatile LAS unsigned*)(lds + WSCR_OFF));
#define GRID_BAR() do { XcdBarrier xb_; unsigned* bw_ = (unsigned*)a_kern.ws + 4096; asm volatile("" : "+s"(bw_)); xb_.bar = bw_; xb_.x = xb_xcc_id(); xb_.st = (volatile LAS unsigned*)(lds + WSCR_OFF); xcd_barrier(xb_); } while (0)
#define PHASE_ARGS() const __attribute__((address_space(4))) Args* ap = (const __attribute__((address_space(4))) Args*)__builtin_amdgcn_kernarg_segment_ptr(); asm volatile("" : "+s"(ap)); \
    bf16_t* WinT = (bf16_t*)(ap->ws + ap->off_wint); bf16_t* WpT = (bf16_t*)(ap->ws + ap->off_wpt); bf16_t* WoT = (bf16_t*)(ap->ws + ap->off_wot); \
    bf16_t* H = (bf16_t*)(ap->ws + ap->off_h); bf16_t* P = (bf16_t*)(ap->ws + ap->off_p); bf16_t* OG = (bf16_t*)(ap->ws + ap->off_og); bf16_t* MB = H; bf16_t* KV = (bf16_t*)(ap->ws + ap->off_kv); \
    (void)KV; (void)WinT; (void)WpT; (void)WoT; (void)H; (void)P; (void)OG; (void)MB
#define PHASE_IDS() PHASE_ARGS(); int tid = threadIdx.x; asm volatile("" : "+v"(tid)); const int lane = tid & 63, wave = __builtin_amdgcn_readfirstlane(tid >> 6), gw = bid * NWAVES + wave, r = lane & 31, h = lane >> 5; \
    (void)gw; (void)r; (void)h
    const int MC = a_kern.MC, NCH = NTOK / MC;

    {
        PHASE_IDS();
        LAS float* scr = (LAS float*)(lds + wave * 16384);
        constexpr int I_IN = 16 * (LDP / 32), I_PJ = 8 * 32, I_OUT = 16 * 32, PER_L = I_IN + 3 * I_PJ + I_OUT;
        for (int it = gw; it < 2 * PER_L; it += NGW) {
            const int l = it / PER_L; int q = it - l * PER_L;
            if (q < I_IN) { transpose_item(ap->w_in + (size_t)l * DM * LDP, DM, LDP, WinT + (size_t)l * LDP * DM, true, scr, q, lane); continue; } q -= I_IN;
            if (q < 3 * I_PJ) { const int b = q / I_PJ; q -= b * I_PJ; const float* W = (b == 0 ? ap->w_proj_a : (b == 1 ? ap->w_proj_b : ap->w_proj_c)) + (size_t)l * 512 * DM;
                transpose_item(W, 512, DM, WpT + ((size_t)l * 3 + b) * DM * 512, false, scr, q, lane); continue; } q -= 3 * I_PJ;
            transpose_item(ap->w_out + (size_t)l * DM * DM, DM, DM, WoT + (size_t)l * DM * DM, false, scr, q, lane);
        }
        __syncthreads();
    }

    for (int ch = 0; ch < NCH; ++ch) {
        const int tok0 = ch * MC; const bool is_prompt = tok0 < NTOK_PROMPT;
        const int T = is_prompt ? T_PROMPT : T_SAMPLE;
        for (int l = 0; l < 2; ++l) {
            {
                PHASE_IDS();
                float* xout = ap->out + (size_t)tok0 * DM;
                const float* xin = (l == 0) ? (is_prompt ? ap->x_prompt + (size_t)tok0 * DM : ap->x_sample + (size_t)(tok0 - NTOK_PROMPT) * DM) : xout;
                const float* g = ap->norm_g + l * DM;
                f32x4 gv[4];
#pragma unroll
                for (int j = 0; j < 4; ++j) gv[j] = ((const f32x4*)g)[lane + 64 * j];
                for (int row = gw; row < MC; row += 2 * NGW) {
                    const int row2 = row + NGW; const bool has2 = row2 < MC;
                    const f32x4* xr = (const f32x4*)(xin + (size_t)row * DM) + lane;
                    const f32x4* xr2 = (const f32x4*)(xin + (size_t)(has2 ? row2 : row) * DM) + lane;
                    f32x4 v[4], v2[4]; float s = 0.f, s2 = 0.f;
#pragma unroll
                    for (int j = 0; j < 4; ++j) { v[j] = xr[64 * j]; v2[j] = xr2[64 * j]; }
#pragma unroll
                    for (int j = 0; j < 4; ++j) { s += (v[j].x * v[j].x + v[j].y * v[j].y) + (v[j].z * v[j].z + v[j].w * v[j].w); s2 += (v2[j].x * v2[j].x + v2[j].y * v2[j].y) + (v2[j].z * v2[j].z + v2[j].w * v2[j].w); }
                    const float rstd = 1.0f / sqrtf(wave_sum(s) * (1.f / DM) + EPS), rstd2 = 1.0f / sqrtf(wave_sum(s2) * (1.f / DM) + EPS);
                    u32x2* o8 = (u32x2*)(H + (size_t)row * DM) + lane;
#pragma unroll
                    for (int j = 0; j < 4; ++j) { u32x2 w; w.x = cvtpk(v[j].x * rstd * gv[j].x, v[j].y * rstd * gv[j].y); w.y = cvtpk(v[j].z * rstd * gv[j].z, v[j].w * rstd * gv[j].w); o8[64 * j] = w; }
                    if (has2) {
                        u32x2* o82 = (u32x2*)(H + (size_t)row2 * DM) + lane;
#pragma unroll
                        for (int j = 0; j < 4; ++j) { u32x2 w; w.x = cvtpk(v2[j].x * rstd2 * gv[j].x, v2[j].y * rstd2 * gv[j].y); w.y = cvtpk(v2[j].z * rstd2 * gv[j].z, v2[j].w * rstd2 * gv[j].w); o82[64 * j] = w; }
                    }
                }
            }
            if (ch == 0 && l == 0) grid.sync(); else GRID_BAR();
            {
                PHASE_ARGS();
                pg8::Gemm g{H, WinT + (size_t)l * LDP * DM, MC, LDP, DM, 0, 0};
                pg8::StaticOrder<LDP, 1> S; S.init(MC, G, bid);
                pg8::EpiInProj E{P, ap->qk_gain_a + l * 128, ap->qk_gain_b + l * 128, ap->qk_gain_c + l * 128, KV, MC};
                pg8::gemm_phase<pg8::EpiInProj, pg8::StaticOrder<LDP, 1>, 1024, 1>(lds, g, S, E);
            }
            GRID_BAR();
            {
                PHASE_IDS();
                const float lam_init = (l == 0) ? 0.2f : 0.35550906759f;
                float lam;
                { const float* lv = ap->lambda_a + l * 256; const float d01 = wave_sum(lv[lane] * lv[64 + lane]), d23 = wave_sum(lv[128 + lane] * lv[192 + lane]); lam = expf(d01) - expf(d23) + lam_init; }
                const float oneml = 1.f - lam_init;
                bf16_t* OGA = OG; bf16_t* OGB = OG + (size_t)MC * 512; bf16_t* OGC = OG + (size_t)2 * MC * 512;
                {
                    float smax2;
                    { const float* ga = ap->qk_gain_a + l * 128; float gq = fabsf(ga[lane]), gk = fabsf(ga[64 + lane]);
#pragma unroll
                      for (int o_ = 1; o_ < 64; o_ <<= 1) { gq = fmaxf(gq, __shfl_xor(gq, o_)); gk = fmaxf(gk, __shfl_xor(gk, o_)); }
                      smax2 = 8.f * gq * gk * LOG2E; }
                    const int qbs = T / 128, npair = MC / 128, nA = npair * 4;
                    const int sub = wave >> 2;
                    unsigned* qctr = (unsigned*)ap->ws + 8192 + 64 * (ch * 2 + l);
                    volatile LAS int* ubox = (volatile LAS int*)(lds + WSCR_OFF + 16);
                    for (;;) {
                        if (tid == 0) ubox[0] = (int)__hip_atomic_fetch_add(qctr, 1u, __ATOMIC_RELAXED, __HIP_MEMORY_SCOPE_AGENT);
                        __syncthreads();
                        const int u = __builtin_amdgcn_readfirstlane(ubox[0]);
                        __syncthreads();
                        if (u >= nA) break;
                        const int pair = u % npair, head = 3 - u / npair, qb = pair % qbs, seq = pair / qbs;
                        const int seqtok = seq * T, q0 = qb * 128, qw = q0 + 32 * (wave & 3);
                        const float sl2 = exp2f(-2.f * (float)(head + 1)) * LOG2E;
                        const int Dh = (int)fminf(ceilf((2.f * smax2 + 150.f) / sl2) + 1.f, 16777216.f);
                        const int t_lo = max(0, (q0 - Dh) / 64), t_hi = min(T / 64 - 1, (q0 + 127 + Dh) / 64), nt = t_hi - t_lo + 1;
                        const bf16_t* qp = P + (size_t)(seqtok + qw + r) * LDP + QA + head * 128 + sub * 64 + 8 * h;
                        bf16x8 qf[4];
#pragma unroll
                        for (int sd = 0; sd < 4; ++sd) qf[sd] = *(const bf16x8*)(qp + 16 * sd);
                        f32x16 o[4] = {}; float m = -INFINITY, lsum = 0.f;
                        const bf16_t* kva = KV + ((size_t)head * MC + seqtok + 64 * t_lo) * 256;
                        {
                            BiasA bf; bf.fixm = (smax2 <= 40.f); bf.sl2 = sl2; bf.q = qw + r - 4 * h - 64 * t_lo; bf.dqh = 0.f; bf.M = bf.fixm ? smax2 : 0.f; bf.init_mfma(qw - 64 * t_lo, r, h);
                            flash<128, 128, 128, 64, 256, BiasA>(lds, kva, kva + 128, nt, qf, sub * 64, 0, bf, o, m, lsum, tid, lane);
                        }
                        const float inv = 1.0f / (lsum + __shfl_xor(lsum, 32));
#pragma unroll
                        for (int db = 0; db < 4; ++db)
#pragma unroll
                            for (int i = 0; i < 16; ++i) o[db][i] *= inv;
                        LAS float* cb = (LAS float*)lds + ((wave & 3) * 32 + r) * 132 + 4 * h;
                        if (sub == 1) {
#pragma unroll
                            for (int db = 0; db < 4; ++db)
#pragma unroll
                                for (int g = 0; g < 4; ++g) *(LAS f32x4*)(cb + 32 * db + 8 * g) = (f32x4){o[db][4 * g], o[db][4 * g + 1], o[db][4 * g + 2], o[db][4 * g + 3]};
                        }
                        __syncthreads();
                        if (sub == 0) {
                            float ss = 0.f;
#pragma unroll
                            for (int db = 0; db < 4; ++db)
#pragma unroll
                                for (int g = 0; g < 4; ++g) { const f32x4 c4 = *(LAS f32x4*)(cb + 32 * db + 8 * g);
#pragma unroll
                                    for (int e = 0; e < 4; ++e) { const float v = o[db][4 * g + e] - lam * c4[e]; o[db][4 * g + e] = v; ss += v * v; } }
                            ss += __shfl_xor(ss, 32);
                            const float rstd = oneml / sqrtf(ss * (1.f / 128.f) + EPS);
                            const size_t tok = (size_t)(seqtok + qw + r);
                            const float* sg = ap->subln_g_a + l * 128 + 4 * h;
                            const bf16_t* zp = P + tok * LDP + ZA + head * 128 + 4 * h;
                            bf16_t* op = OGA + tok * 512 + head * 128 + 4 * h;
#pragma unroll
                            for (int db = 0; db < 4; ++db)
#pragma unroll
                                for (int g = 0; g < 4; ++g) {
                                    const f32x4 s4 = *(const f32x4*)(sg + 32 * db + 8 * g); const u32x2 z2 = *(const u32x2*)(zp + 32 * db + 8 * g);
                                    const float y0 = o[db][4 * g] * rstd * s4[0] * __uint_as_float(z2.x << 16), y1 = o[db][4 * g + 1] * rstd * s4[1] * __uint_as_float(z2.x & 0xffff0000u);
                                    const float y2 = o[db][4 * g + 2] * rstd * s4[2] * __uint_as_float(z2.y << 16), y3 = o[db][4 * g + 3] * rstd * s4[3] * __uint_as_float(z2.y & 0xffff0000u);
                                    u32x2 w; w.x = cvtpk(y0, y1); w.y = cvtpk(y2, y3); *(u32x2*)(op + 32 * db + 8 * g) = w;
                                }
                        }
                        __syncthreads();
                    }
                }
                {
                    const int rows = T / 64, nB = (MC / 64) * 2;
                    LAS float* tab = (LAS float*)(lds + TAB_OFF);
                    const int perB = (nB + G - 1) / G;
                    for (int u = vb * perB; u < min(nB, (vb + 1) * perB); ++u) {
                        const int hg4 = u & 1, grow = u >> 1, seq = grow / rows, gr = grow % rows, seqtok = seq * T;
                        const int rs = min(max(gr - 4, 0), rows - 8);
                        const int head = hg4 * 4 + (wave >> 1), qc = 32 * (wave & 1) + r;
                        { const float* src = ap->rpb_b + ((size_t)l * 8 + hg4 * 4) * 465; for (int i = tid; i < 4 * 465; i += NTHREADS) tab[i] = src[i] * LOG2E; }
                        const size_t qtok = (size_t)(seqtok + gr * 64 + qc);
                        const bf16_t* qp = P + qtok * LDP + QB + head * 64 + 8 * h;
                        bf16x8 qf[4];
#pragma unroll
                        for (int sd = 0; sd < 4; ++sd) qf[sd] = *(const bf16x8*)(qp + 16 * sd);
                        BiasB bf; bf.hsel = wave & 1; bf.tabh = tab + (wave >> 1) * 465; bf.trow = bf.tabh; bf.qc = qc; bf.cs = min(max(qc - 8, 0), 48); bf.kc0 = 0; bf.rs_minus_gr = rs - gr; bf.h4 = 4 * h;
                        f32x16 o[2] = {}; float m = -INFINITY, lsum = 0.f;
                        const bf16_t* kvb = KV + (size_t)4 * MC * 256 + ((size_t)hg4 * MC + seqtok + rs * 64) * 512;
                        flash<64, 256, 256, 64, 512, BiasB>(lds, kvb, kvb + 256, 8, qf, (wave >> 1) * 64, (wave >> 1) * 64, bf, o, m, lsum, tid, lane);
                        const float inv = 1.0f / (lsum + __shfl_xor(lsum, 32));
                        const size_t tok = qtok;
                        const bf16_t* zp = P + tok * LDP + ZB + head * 64 + 4 * h;
                        bf16_t* op = OGB + tok * 512 + head * 64 + 4 * h;
#pragma unroll
                        for (int db = 0; db < 2; ++db)
#pragma unroll
                            for (int g = 0; g < 4; ++g) {
                                const u32x2 z2 = *(const u32x2*)(zp + 32 * db + 8 * g);
                                const float y0 = o[db][4 * g] * inv * __uint_as_float(z2.x << 16), y1 = o[db][4 * g + 1] * inv * __uint_as_float(z2.x & 0xffff0000u);
                                const float y2 = o[db][4 * g + 2] * inv * __uint_as_float(z2.y << 16), y3 = o[db][4 * g + 3] * inv * __uint_as_float(z2.y & 0xffff0000u);
                                u32x2 w; w.x = cvtpk(y0, y1); w.y = cvtpk(y2, y3); *(u32x2*)(op + 32 * db + 8 * g) = w;
                            }
                    }
                }
                {
                    const int qbs = T / 64, nC = (MC / 64) * 2;
                    const int perC = (nC + G - 1) / G;
                    for (int u = vb * perC; u < min(nC, (vb + 1) * perC); ++u) {
                        const int kv = u & 1, qq = u >> 1, seq = qq / qbs, qb = qq % qbs, seqtok = seq * T;
                        const int head = kv * 4 + (wave >> 1), qpos = qb * 64 + 32 * (wave & 1) + r;
                        const int t_lo = max(0, 2 - qb), t_hi = min(4, qbs + 1 - qb), nt = t_hi - t_lo + 1, key0 = qb * 64 - 128 + 64 * t_lo;
                        const bf16_t* qp = P + (size_t)(seqtok + qpos) * LDP + QC + head * 64 + 8 * h;
                        bf16x8 qf[4];
#pragma unroll
                        for (int sd = 0; sd < 4; ++sd) qf[sd] = *(const bf16x8*)(qp + 16 * sd);
                        BiasC bf; bf.sl2 = exp2f(-(float)(head + 1)) * LOG2E; bf.q = qpos - key0 - 4 * h; bf.dqh = 0.f;
                        f32x16 o[2] = {}; float m = -INFINITY, lsum = 0.f;
                        const bf16_t* kvc = KV + (size_t)4 * MC * 256 + (size_t)2 * MC * 512 + ((size_t)kv * MC + seqtok + key0) * 128;
                        flash<64, 64, 64, 64, 128, BiasC>(lds, kvc, kvc + 64, nt, qf, 0, 0, bf, o, m, lsum, tid, lane);
                        const float inv = 1.0f / (lsum + __shfl_xor(lsum, 32) + __builtin_amdgcn_exp2f(ap->sink_c[l * 8 + head] * LOG2E - m));
                        const size_t tok = (size_t)(seqtok + qpos);
                        const bf16_t* zp = P + tok * LDP + ZC + head * 64 + 4 * h;
                        bf16_t* op = OGC + tok * 512 + head * 64 + 4 * h;
#pragma unroll
                        for (int db = 0; db < 2; ++db)
#pragma unroll
                            for (int g = 0; g < 4; ++g) {
                                const u32x2 z2 = *(const u32x2*)(zp + 32 * db + 8 * g);
                                const float y0 = o[db][4 * g] * inv * __uint_as_float(z2.x << 16), y1 = o[db][4 * g + 1] * inv * __uint_as_float(z2.x & 0xffff0000u);
                                const float y2 = o[db][4 * g + 2] * inv * __uint_as_float(z2.y << 16), y3 = o[db][4 * g + 3] * inv * __uint_as_float(z2.y & 0xffff0000u);
                                u32x2 w; w.x = cvtpk(y0, y1); w.y = cvtpk(y2, y3); *(u32x2*)(op + 32 * db + 8 * g) = w;
                            }
                    }
                }
            }
            GRID_BAR();
            {
                PHASE_ARGS();
                pg8::Gemm g{OG, WpT + (size_t)l * 3 * DM * 512, MC, DM, 512, (size_t)MC * 512, (size_t)DM * 512};
                pg8::StaticOrder<DM, 3> S; S.init(MC, G, bid);
                pg8::EpiProjGate E{P, MB};
                pg8::gemm_phase<pg8::EpiProjGate, pg8::StaticOrder<DM, 3>, 512, 3>(lds, g, S, E);
            }
            GRID_BAR();
            {
                PHASE_ARGS();
                float* xout = ap->out + (size_t)tok0 * DM;
                const float* xin = (l == 0) ? (is_prompt ? ap->x_prompt + (size_t)tok0 * DM : ap->x_sample + (size_t)(tok0 - NTOK_PROMPT) * DM) : xout;
                pg8::Gemm g{MB, WoT + (size_t)l * DM * DM, MC, DM, DM, 0, 0};
                pg8::StaticOrder<DM, 1> S; S.init(MC, G, bid);
                pg8::EpiResid E{xin, xout};
                pg8::gemm_phase<pg8::EpiResid, pg8::StaticOrder<DM, 1>, 1024, 1>(lds, g, S, E);
            }
            if (!(ch == NCH - 1 && l == 1)) GRID_BAR();
        }
    }
}

extern "C" void kernel_launch(void* const* d_in, const int* in_sizes, int n_in, void* d_out, int out_size, void* d_ws, size_t ws_size, hipStream_t stream) {
    static int grid_blocks = 0;
    if (grid_blocks == 0) {
        int dev = 0, cus = 0, per_cu = 0;
        hipGetDevice(&dev);
        hipDeviceGetAttribute(&cus, hipDeviceAttributeMultiprocessorCount, dev);
        if (hipFuncSetAttribute((const void*)mega_fwd, hipFuncAttributeMaxDynamicSharedMemorySize, LDS_BYTES) != hipSuccess) fprintf(stderr, "hipFuncSetAttribute failed\n");
        if (hipOccupancyMaxActiveBlocksPerMultiprocessor(&per_cu, (const void*)mega_fwd, NTHREADS, LDS_BYTES) != hipSuccess || per_cu < 1) { fprintf(stderr, "occupancy query: %d\n", per_cu); per_cu = 1; }
        (void)hipGetLastError();
        grid_blocks = cus * 1;
        if (grid_blocks <= 0) grid_blocks = 256;
    }
    Args a{};
    a.x_prompt = (const float*)d_in[0]; a.x_sample = (const float*)d_in[1]; a.norm_g = (const float*)d_in[2]; a.w_in = (const float*)d_in[3];
    a.qk_gain_a = (const float*)d_in[4]; a.lambda_a = (const float*)d_in[5]; a.subln_g_a = (const float*)d_in[6]; a.qk_gain_b = (const float*)d_in[7];
    a.rpb_b = (const float*)d_in[8]; a.qk_gain_c = (const float*)d_in[9]; a.sink_c = (const float*)d_in[10]; a.w_proj_a = (const float*)d_in[11];
    a.w_proj_b = (const float*)d_in[12]; a.w_proj_c = (const float*)d_in[13]; a.w_out = (const float*)d_in[14];
    a.out = (float*)d_out; a.ws = (unsigned char*)d_ws;
    const unsigned long long MiB = 1ull << 20;
    a.off_wint = 1 * MiB; a.off_wpt = 35 * MiB; a.off_wot = 42 * MiB; a.off_h = 47 * MiB;
    int MC = 32768;
    auto need = [&](int mc) { return 47 * MiB + (unsigned long long)mc * DM * 2 + (unsigned long long)mc * LDP * 2 + (unsigned long long)mc * 1536 * 2 + (unsigned long long)mc * 2304 * 2; };
    if (need(MC) > ws_size) MC = 16384;
    if (need(MC) > ws_size) { fprintf(stderr, "kernel_launch: workspace too small (%zu)\n", ws_size); return; }
    a.MC = MC; a.pad = 0;
    a.off_p = a.off_h + (unsigned long long)MC * DM * 2;
    a.off_og = a.off_p + (unsigned long long)MC * LDP * 2;
    a.off_kv = a.off_og + (unsigned long long)MC * 1536 * 2;
    if (hipMemsetAsync(d_ws, 0, 65536, stream) != hipSuccess) fprintf(stderr, "kernel_launch: memset failed\n");
    void* args[] = {&a};
    hipError_t e = hipLaunchCooperativeKernel((const void*)mega_fwd, dim3(grid_blocks), dim3(NTHREADS), args, LDS_BYTES, stream);
    if (e != hipSuccess) fprintf(stderr, "cooperative launch failed: %s (grid %d)\n", hipGetErrorString(e), grid_blocks);
}
```
